# Optimizing an MI355X kernel written in HIP

```python
import functools
import jax
import jax.numpy as jnp
from jax import lax
import numpy as np

D_MODEL = 1024
BATCH = 4
SEQ = 4096
DEPTH = 4

GRID_W = 64
CTX_LEN = 256
HEAD_DIM = 64
N_EVEN = (DEPTH + 1) // 2
N_ODD = DEPTH // 2

NA_HEADS = 8
NA_WIN_H_MAX = 8
NA_WIN_W = 16
NA_WIDTH = NA_HEADS * HEAD_DIM
GLA_HEADS = 4
GLA_DK = 64
GLA_DV = 128
GLA_KW = GLA_HEADS * GLA_DK
GLA_VW = GLA_HEADS * GLA_DV
GLA_GATE_RANK = 16
GLA_TAU = 16.0
GLA_CHUNK = 64
AB_SIZES = (NA_WIDTH, NA_WIDTH, NA_WIDTH, GLA_KW, GLA_KW, GLA_VW, GLA_VW, GLA_GATE_RANK, GLA_GATE_RANK)
IN_AB = 3 * NA_WIDTH + 2 * GLA_KW + 2 * GLA_VW + 2 * GLA_GATE_RANK
SWA_HEADS = 16
SWA_KV_HEADS = 4
SWA_GROUP = SWA_HEADS // SWA_KV_HEADS
SWA_WINDOW = 128
SWA_BLOCK = 128
IN_C = (SWA_HEADS + 2 * SWA_KV_HEADS) * HEAD_DIM
D_FF = 2816
CONV_W = 3
ROPE_BASE = 10000.0
ROPE_AXIS_DIM = HEAD_DIM // 2
EPS = 1e-6
NEG_INF = -1e30

kernel_name = 'hybrid_na_gla_swa_prefix_dit_trunk'


def rmsnorm(x, g):
    xf = x.astype(jnp.float32)
    y = xf * lax.rsqrt(jnp.mean(xf * xf, axis=-1, keepdims=True) + EPS)
    return (y * g.astype(jnp.float32)).astype(x.dtype)


def modulate(h, shift, scale):
    return h * (1 + scale) + shift


def axial_rope_tables(n):
    t = jnp.arange(n)
    row = (t // GRID_W).astype(jnp.float32)
    col = (t % GRID_W).astype(jnp.float32)
    inv = 1.0 / (ROPE_BASE ** (jnp.arange(0, ROPE_AXIS_DIM, 2, dtype=jnp.float32) / ROPE_AXIS_DIM))
    ang = jnp.concatenate([row[:, None] * inv, col[:, None] * inv], axis=-1)
    return jnp.cos(ang), jnp.sin(ang)


def apply_rope(x, cos, sin):
    shp = (1, cos.shape[0]) + (1,) * (x.ndim - 3) + (cos.shape[1],)
    cos, sin = cos.reshape(shp), sin.reshape(shp)
    x1, x2 = x[..., 0::2], x[..., 1::2]
    out = jnp.stack([x1 * cos - x2 * sin, x1 * sin + x2 * cos], axis=-1)
    return out.reshape(x.shape).astype(x.dtype)


def joint_softmax(parts, sink=None):
    m = functools.reduce(jnp.maximum, [jnp.max(s, axis=-1, keepdims=True) for s in parts])
    if sink is not None:
        m = jnp.maximum(m, sink)
    ps = [jnp.exp(s - m) for s in parts]
    den = functools.reduce(jnp.add, [jnp.sum(p, axis=-1, keepdims=True) for p in ps])
    if sink is not None:
        den = den + jnp.exp(sink - m)
    return [p / den for p in ps]


def context_attention(q, k, v):
    B, n, H, d = q.shape
    s = jnp.einsum('bqhd,bkhd->bhqk', q, k).astype(jnp.float32) * d ** -0.5
    p = jax.nn.softmax(s, axis=-1).astype(v.dtype)
    return jnp.einsum('bhqk,bkhd->bqhd', p, v).reshape(B, n, H * d)


def neighbourhood_attention(q, k, v, k_ctx, v_ctx, rpb):
    B, S, H, d = q.shape
    rows = S // GRID_W
    kh = min(NA_WIN_H_MAX, rows)
    r = jnp.arange(rows)
    r_start = jnp.clip(r - kh // 2, 0, rows - kh)
    row_idx = r_start[:, None] + jnp.arange(kh)[None, :]
    cidx = jnp.arange(GRID_W)
    c_start = jnp.clip(cidx - NA_WIN_W // 2, 0, GRID_W - NA_WIN_W)
    col_ok = (cidx[None, :] >= c_start[:, None]) & (cidx[None, :] < c_start[:, None] + NA_WIN_W)
    dr = row_idx - r[:, None] + (NA_WIN_H_MAX - 1)
    dc = jnp.clip(cidx[None, :] - cidx[:, None] + NA_WIN_W - 1, 0, 2 * NA_WIN_W - 2)
    bias = rpb[:, dr[:, None, :, None], dc[None, :, None, :]].astype(jnp.float32)
    bias = jnp.where(col_ok[None, None, :, None, :], bias, NEG_INF).reshape(H, rows, GRID_W, kh * GRID_W)
    qg = q.reshape(B, rows, GRID_W, H, d)
    kg = jnp.take(k.reshape(B, rows, GRID_W, H, d), row_idx, axis=1).reshape(B, rows, kh * GRID_W, H, d)
    vg = jnp.take(v.reshape(B, rows, GRID_W, H, d), row_idx, axis=1).reshape(B, rows, kh * GRID_W, H, d)
    scale = d ** -0.5
    s_lat = jnp.einsum('brqhd,brkhd->bhrqk', qg, kg).astype(jnp.float32) * scale + bias[None]
    s_ctx = jnp.einsum('brqhd,bchd->bhrqc', qg, k_ctx).astype(jnp.float32) * scale
    p_lat, p_ctx = joint_softmax([s_lat, s_ctx])
    o = (jnp.einsum('bhrqk,brkhd->brqhd', p_lat.astype(v.dtype), vg)
         + jnp.einsum('bhrqc,bchd->brqhd', p_ctx.astype(v.dtype), v_ctx))
    return o.reshape(B, S, H * d)


def gla_log_decay(z_low, w2, b):
    z = z_low.astype(jnp.float32) @ w2.astype(jnp.float32) + b.astype(jnp.float32)
    return jax.nn.log_sigmoid(z) / GLA_TAU


def gla_chunked(q, k, v, log_a, s0, with_output):
    B, T, H, dk = k.shape
    dv = v.shape[-1]
    n = T // GLA_CHUNK
    blk = lambda t: t.astype(jnp.float32).reshape(B, n, GLA_CHUNK, H, t.shape[-1])
    kc, vc = blk(k), blk(v)
    b = jnp.cumsum(blk(log_a), axis=2)
    b_last = b[:, :, -1:]
    d_state = jnp.einsum('bnchd,bnchv->bnhdv', kc * jnp.exp(b_last - b), vc)
    decay = jnp.exp(b_last[:, :, 0])

    def step(s, inp):
        dec, ds = inp
        return dec[..., None] * s + ds, (s if with_output else None)

    s_final, s_in = lax.scan(step, s0, (jnp.moveaxis(decay, 1, 0), jnp.moveaxis(d_state, 1, 0)))
    if not with_output:
        return None, s_final
    qt = blk(q) * jnp.exp(b)
    kt = kc * jnp.exp(-b)
    tri = jnp.tril(jnp.ones((GLA_CHUNK, GLA_CHUNK), dtype=bool))
    att = jnp.where(tri, jnp.einsum('bnqhd,bnkhd->bnhqk', qt, kt), 0.0)
    o = jnp.einsum('bnhqk,bnkhv->bnqhv', att, vc) + jnp.einsum('bnqhd,nbhdv->bnqhv', qt, s_in)
    return o.reshape(B, T, H, dv), s_final


def gla_output(o, r, g):
    B, T = o.shape[:2]
    on = (o * lax.rsqrt(jnp.mean(o * o, axis=-1, keepdims=True) + EPS)).reshape(B, T, GLA_VW)
    return on.astype(r.dtype) * g * jax.nn.silu(r)


def project_na_gla(h, w_in, wa2, ba):
    B, n, _ = h.shape
    cuts, acc = [], 0
    for size in AB_SIZES[:-1]:
        acc += size
        cuts.append(acc)
    qa, ka, va, qb, kb, vb, rb, z_fwd, z_bwd = jnp.split(h @ w_in, cuts, axis=-1)
    na = lambda t: t.reshape(B, n, NA_HEADS, HEAD_DIM)
    gk = lambda t: t.reshape(B, n, GLA_HEADS, GLA_DK)
    la = (gk(gla_log_decay(z_fwd, wa2[0], ba[0])), gk(gla_log_decay(z_bwd, wa2[1], ba[1])))
    return (na(qa), na(ka), na(va), gk(qb) * GLA_DK ** -0.5, gk(kb),
            vb.reshape(B, n, GLA_HEADS, GLA_DV), rb, la)


def mixer_na_gla(hc, hl, w_in, rpb, wa2, ba, g_out, need_ctx):
    qa_c, ka_c, va_c, qb_c, kb_c, vb_c, rb_c, la_c = project_na_gla(hc, w_in, wa2, ba)
    qa_l, ka_l, va_l, qb_l, kb_l, vb_l, rb_l, la_l = project_na_gla(hl, w_in, wa2, ba)
    flip = lambda t: jnp.flip(t, axis=1)
    zero = jnp.zeros((hl.shape[0], GLA_HEADS, GLA_DK, GLA_DV), jnp.float32)
    o_cf, s_cf = gla_chunked(qb_c, kb_c, vb_c, la_c[0], zero, need_ctx)
    o_cb, s_cb = gla_chunked(flip(qb_c), flip(kb_c), flip(vb_c), flip(la_c[1]), zero, need_ctx)
    o_lf, _ = gla_chunked(qb_l, kb_l, vb_l, la_l[0], s_cf, True)
    o_lb, _ = gla_chunked(flip(qb_l), flip(kb_l), flip(vb_l), flip(la_l[1]), s_cb, True)
    y_l = jnp.concatenate([neighbourhood_attention(qa_l, ka_l, va_l, ka_c, va_c, rpb),
                           gla_output(o_lf + flip(o_lb), rb_l, g_out)], axis=-1)
    y_c = None
    if need_ctx:
        y_c = jnp.concatenate([context_attention(qa_c, ka_c, va_c),
                               gla_output(o_cf + flip(o_cb), rb_c, g_out)], axis=-1)
    return y_c, y_l


def mixer_swa(hc, hl, w_in, sink, cos, sin, need_ctx):
    B, T, _ = hl.shape
    KV, G, d = SWA_KV_HEADS, SWA_GROUP, HEAD_DIM
    cut_q, cut_k = SWA_HEADS * d, (SWA_HEADS + KV) * d

    def proj(h):
        n = h.shape[1]
        q, k, v = jnp.split(h @ w_in, [cut_q, cut_k], axis=-1)
        return q.reshape(B, n, KV, G, d), k.reshape(B, n, KV, d), v.reshape(B, n, KV, d)

    qc, kc, vc = proj(hc)
    ql, kl, vl = proj(hl)
    ql, kl = apply_rope(ql, cos, sin), apply_rope(kl, cos, sin)
    scale = d ** -0.5
    sink_f = sink.astype(jnp.float32).reshape(KV, G)
    nb = T // SWA_BLOCK
    qb = ql.reshape(B, nb, SWA_BLOCK, KV, G, d)

    def band(t):
        tp = jnp.pad(t.reshape(B, nb, SWA_BLOCK, KV, d), ((0, 0), (1, 1), (0, 0), (0, 0), (0, 0)))
        return jnp.concatenate([tp[:, :-2], tp[:, 1:-1], tp[:, 2:]], axis=2)

    kb, vb = band(kl), band(vl)
    qpos = jnp.arange(T).reshape(nb, SWA_BLOCK)
    kpos = jnp.arange(nb)[:, None] * SWA_BLOCK + jnp.arange(-SWA_BLOCK, 2 * SWA_BLOCK)[None, :]
    ok = ((jnp.abs(qpos[:, :, None] - kpos[:, None, :]) <= SWA_WINDOW)
          & (kpos[:, None, :] >= 0) & (kpos[:, None, :] < T))
    s_lat = jnp.einsum('bnqhgd,bnmhd->bhgnqm', qb, kb).astype(jnp.float32) * scale
    s_lat = jnp.where(ok[None, None, None], s_lat, NEG_INF)
    s_ctx = jnp.einsum('bnqhgd,bchd->bhgnqc', qb, kc).astype(jnp.float32) * scale
    p_lat, p_ctx = joint_softmax([s_lat, s_ctx], sink_f[None, :, :, None, None, None])
    o = (jnp.einsum('bhgnqm,bnmhd->bnqhgd', p_lat.astype(vb.dtype), vb)
         + jnp.einsum('bhgnqc,bchd->bnqhgd', p_ctx.astype(vc.dtype), vc))
    y_l = o.reshape(B, T, SWA_HEADS * d)
    y_c = None
    if need_ctx:
        s_cc = jnp.einsum('bqhgd,bchd->bhgqc', qc, kc).astype(jnp.float32) * scale
        (p_cc,) = joint_softmax([s_cc], sink_f[None, :, :, None, None])
        y_c = jnp.einsum('bhgqc,bchd->bqhgd', p_cc.astype(vc.dtype), vc).reshape(B, hc.shape[1], SWA_HEADS * d)
    return y_c, y_l


def conv_ffn(h, w_up, conv_w, conv_b, w_down):
    u = h @ w_up
    T = u.shape[1]
    pad = CONV_W // 2
    up = jnp.pad(u, ((0, 0), (pad, pad), (0, 0)))
    u = functools.reduce(jnp.add, [up[:, t:t + T] * conv_w[t] for t in range(CONV_W)]) + conv_b
    gate, val = jnp.split(u, 2, axis=-1)
    return (jax.nn.silu(gate) * val) @ w_down


def setup_inputs(seed: int = 0) -> dict:
    key = jax.random.key(seed)
    ks = iter(jax.random.split(key, 32))
    f32 = jnp.float32
    D = D_MODEL

    def w(shape, fan_in, s=1.0):
        return jax.random.normal(next(ks), shape, f32) * (s * fan_in ** -0.5)

    def gain(shape):
        return 1.0 + 0.1 * jax.random.normal(next(ks), shape, f32)

    def small(shape, s=0.02):
        return s * jax.random.normal(next(ks), shape, f32)

    return {
        'x': jax.random.normal(next(ks), (BATCH, SEQ, D), f32),
        'c': jax.random.normal(next(ks), (BATCH, D), f32),
        'ctx': jax.random.normal(next(ks), (BATCH, CTX_LEN, D), f32),
        'c_ctx': jax.random.normal(next(ks), (D,), f32),
        'w_mod': w((DEPTH, D, 6 * D), D, 0.5),
        'b_mod': small((DEPTH, 6 * D)),
        'g_mix_pre': gain((DEPTH, D)),
        'g_mix_post': gain((DEPTH, D)),
        'g_ffn_pre': gain((DEPTH, D)),
        'g_ffn_post': gain((DEPTH, D)),
        'w_out': w((DEPTH, D, D), D),
        'w_up': w((DEPTH, D, 2 * D_FF), D),
        'conv_w': w((DEPTH, CONV_W, 2 * D_FF), CONV_W),
        'conv_b': small((DEPTH, 2 * D_FF)),
        'w_down': w((DEPTH, D_FF, D), D_FF),
        'w_in_ab': w((N_EVEN, D, IN_AB), D),
        'na_rpb': small((N_EVEN, NA_HEADS, 2 * NA_WIN_H_MAX - 1, 2 * NA_WIN_W - 1), 0.1),
        'gla_wa2': w((N_EVEN, 2, GLA_GATE_RANK, GLA_KW), GLA_GATE_RANK),
        'gla_ba': small((N_EVEN, 2, GLA_KW), 0.1),
        'gla_g': gain((N_EVEN, GLA_VW)),
        'w_in_c': w((N_ODD, D, IN_C), D),
        'swa_sink': jax.random.normal(next(ks), (N_ODD, SWA_HEADS), f32),
    }


def reference(x, c, ctx, c_ctx, w_mod, b_mod, g_mix_pre, g_mix_post, g_ffn_pre, g_ffn_post,
              w_out, w_up, conv_w, conv_b, w_down, w_in_ab, na_rpb, gla_wa2, gla_ba, gla_g,
              w_in_c, swa_sink):
    xl, xc = x, ctx
    cos, sin = axial_rope_tables(x.shape[1])
    s_lat = jax.nn.silu(c)
    s_ctx = jax.nn.silu(c_ctx)
    for i in range(DEPTH):
        need_ctx = i < DEPTH - 1
        j = i // 2
        m_l = jnp.split((s_lat @ w_mod[i] + b_mod[i])[:, None, :], 6, axis=-1)
        m_c = jnp.split(s_ctx @ w_mod[i] + b_mod[i], 6, axis=-1)
        hl = modulate(rmsnorm(xl, g_mix_pre[i]), m_l[0], m_l[1])
        hc = modulate(rmsnorm(xc, g_mix_pre[i]), m_c[0], m_c[1])
        if i % 2 == 0:
            yc, yl = mixer_na_gla(hc, hl, w_in_ab[j], na_rpb[j], gla_wa2[j], gla_ba[j], gla_g[j], need_ctx)
        else:
            yc, yl = mixer_swa(hc, hl, w_in_c[j], swa_sink[j], cos, sin, need_ctx)
        xl = xl + m_l[2] * rmsnorm(yl @ w_out[i], g_mix_post[i])
        hl = modulate(rmsnorm(xl, g_ffn_pre[i]), m_l[3], m_l[4])
        xl = xl + m_l[5] * rmsnorm(conv_ffn(hl, w_up[i], conv_w[i], conv_b[i], w_down[i]), g_ffn_post[i])
        if need_ctx:
            xc = xc + m_c[2] * rmsnorm(yc @ w_out[i], g_mix_post[i])
            hc = modulate(rmsnorm(xc, g_ffn_pre[i]), m_c[3], m_c[4])
            xc = xc + m_c[5] * rmsnorm(conv_ffn(hc, w_up[i], conv_w[i], conv_b[i], w_down[i]), g_ffn_post[i])
    return xl
```

```cpp
#include <hip/hip_runtime.h>
#include <hip/hip_cooperative_groups.h>
#include <cstdio>
namespace cg = cooperative_groups;

#define DI __device__ __forceinline__
typedef unsigned short bfu;
typedef __attribute__((ext_vector_type(8))) short bf16x8;
typedef __attribute__((ext_vector_type(4))) short s16x4;
typedef __attribute__((ext_vector_type(16))) float f32x16;
typedef __attribute__((ext_vector_type(4))) unsigned u32x4;
#define MFMA(a, b, c) __builtin_amdgcn_mfma_f32_32x32x16_bf16((a), (b), (c), 0, 0, 0)

constexpr int D = 1024;
constexpr int PB = 4352;
constexpr int MTOT = 4 * PB;
constexpr int DFF = 2816;
constexpr float EPSF = 1e-6f;
constexpr float NEGF = -1e30f;
constexpr float LOG2E = 1.4426950408889634f;
constexpr float QSCALE = 0.125f * 1.4426950408889634f;
#ifndef REP_GEMM
#define REP_GEMM 1
#endif
#ifndef REP_MIX
#define REP_MIX 1
#endif
#ifndef REP_SYNC
#define REP_SYNC 1
#endif
#ifndef REP_CONV
#define REP_CONV 1
#endif
#ifndef REP_ROWS
#define REP_ROWS 1
#endif

struct Params {
  const float *x, *c, *ctx, *c_ctx, *w_mod, *b_mod, *g_mix_pre, *g_mix_post, *g_ffn_pre, *g_ffn_post;
  const float *w_out, *w_up, *conv_w, *conv_b, *w_down, *w_in_ab, *na_rpb, *gla_wa2, *gla_ba, *gla_g, *w_in_c, *swa_sink;
  float* out;
  bfu *wout_t, *wup_t, *wdown_t, *win_t;
  float *modp, *mod;
  float2* rope;
  float* xres;
  bfu* h;
  float* yo;
  bfu *qa, *ka, *vaT, *qb, *kb;
  bfu *y, *vbT, *rb;
  float *z, *decay;
  bfu* a;
  float* ub;
  bfu* dstate;
  unsigned* bar;
};

DI int tid_l() { int t = threadIdx.x; asm volatile("" : "+v"(t)); return t; }
typedef __bf16 bf2_t __attribute__((ext_vector_type(2)));
typedef float f2_t __attribute__((ext_vector_type(2)));
typedef __attribute__((ext_vector_type(2))) unsigned u32x2;
DI unsigned pk_bf16(float a, float b) { f2_t v = {a, b}; return __builtin_bit_cast(unsigned, __builtin_convertvector(v, bf2_t)); }
DI bfu f2bf(float x) { return (bfu)(pk_bf16(x, 0.f) & 0xffffu); }
DI float bf2f(bfu v) { return __uint_as_float(((unsigned)v) << 16); }
DI int crow(int r, int h) { return (r & 3) + 8 * (r >> 2) + 4 * h; }
DI float wave_sum(float v) {
#pragma unroll
  for (int o = 32; o >= 1; o >>= 1) v += __shfl_xor(v, o);
  return v;
}
DI float siluf(float v) { return v * __builtin_amdgcn_rcpf(1.f + __builtin_amdgcn_exp2f(-1.4426950408889634f * v)); }
DI s16x4 pack4(float a, float b, float c, float d) {
  u32x2 r; r[0] = pk_bf16(a, b); r[1] = pk_bf16(c, d);
  return __builtin_bit_cast(s16x4, r);
}
DI bf16x8 pack8(const float* p) {
  u32x4 r; r[0] = pk_bf16(p[0], p[1]); r[1] = pk_bf16(p[2], p[3]); r[2] = pk_bf16(p[4], p[5]); r[3] = pk_bf16(p[6], p[7]);
  return __builtin_bit_cast(bf16x8, r);
}
DI int kq_off(int p, int d) { return (p >> 5) * 2048 + ((((d >> 4) * 2 + ((d >> 3) & 1)) * 32 + (p & 31)) << 3) + (d & 7); }
DI int v_off(int p, int d) {
  const int pi = p & 31;
  return (p >> 5) * 2048 + ((((((pi >> 4) * 2 + (d >> 5)) * 2 + ((pi >> 2) & 1)) * 32 + (d & 31)) << 3) + ((pi >> 3) & 1) * 4 + (pi & 3));
}
DI int swz(int row, int col) { return row * 64 + ((((col >> 3) ^ (row & 7))) << 3) + (col & 7); }


#define XB_TMO      128
#define XB_XCNT(j)  (256  + 64 * (j))
#define XB_XSUB(j)  (1280 + 64 * (j))
#define XB_XGEN(j)  (2304 + 64 * (j))
#define XB_TOP      3328
#define XB_TOPGEN   3392
#define XCD_BAR_WORDS 3456
#define XB_SPIN_CAP (1u << 22)
#define LAS __attribute__((address_space(3)))
DI unsigned xb_ld(unsigned* p)              { return __hip_atomic_load(p, __ATOMIC_RELAXED, __HIP_MEMORY_SCOPE_AGENT); }
DI unsigned xb_add(unsigned* p, unsigned v) { return __hip_atomic_fetch_add(p, v, __ATOMIC_RELAXED, __HIP_MEMORY_SCOPE_AGENT); }
DI unsigned xb_xcc_id() { return (unsigned)__builtin_amdgcn_s_getreg((3 << 11) | 20) & 0xFu; }
#define XB_SPIN(cond, bar) do { unsigned _sp = 0; while (cond) { __builtin_amdgcn_s_sleep(6); \
    if ((++_sp & 255u) == 0u) { if (xb_ld(&(bar)[XB_TMO])) break; if (_sp > XB_SPIN_CAP) { atomicAdd(&(bar)[XB_TMO], 1u); break; } } } } while (0)
struct XcdBarrier { unsigned* bar; unsigned x; unsigned nloc, nx; };
DI XcdBarrier xcd_barrier_post(unsigned* bar) {
  XcdBarrier b; b.bar = bar; b.x = xb_xcc_id(); b.nloc = 0u; b.nx = 0u;
  if (threadIdx.x == 0) (void)xb_add(&bar[XB_XCNT(b.x)], 1u);
  return b;
}
DI void xcd_barrier_complete(unsigned* bar, unsigned x, unsigned& nloc, unsigned& nx) {
  const unsigned G = gridDim.x * gridDim.y * gridDim.z;
  unsigned sum, cnt, mine, sp = 0u;
  for (;;) {
    sum = 0u; cnt = 0u; mine = 0u;
#pragma unroll
    for (unsigned j = 0; j < 16; ++j) { const unsigned c = xb_ld(&bar[XB_XCNT(j)]); sum += c; cnt += (c > 0u) ? 1u : 0u; mine = (j == x) ? c : mine; }
    if (sum == G) break;
    __builtin_amdgcn_s_sleep(1);
    if ((++sp & 255u) == 0u) { if (xb_ld(&bar[XB_TMO])) break; if (sp > XB_SPIN_CAP) { atomicAdd(&bar[XB_TMO], 1u); break; } }
  }
  nloc = mine > 0u ? mine : 1u; nx = cnt > 0u ? cnt : 1u;
}
DI void xcd_barrier(XcdBarrier& b) {
  asm volatile("s_waitcnt vmcnt(0)" ::: "memory");
  __syncthreads();
  if (threadIdx.x == 0) {
    unsigned* bar = b.bar;
    __builtin_amdgcn_s_waitcnt(0);
    unsigned nloc = b.nloc, nx = b.nx;
    if (nloc == 0u) { xcd_barrier_complete(bar, b.x, nloc, nx); b.nloc = nloc; b.nx = nx; }
    const unsigned old = xb_add(&bar[XB_XSUB(b.x)], 1u);
    const unsigned gen = old / nloc;
    if (old + 1u == (gen + 1u) * nloc) {
      __builtin_amdgcn_fence(__ATOMIC_RELEASE, "agent");
      asm volatile("s_waitcnt vmcnt(0)" ::: "memory");
      const unsigned og = xb_add(&bar[XB_TOP], 1u);
      const unsigned tg = og / nx;
      if (og + 1u == (tg + 1u) * nx) xb_add(&bar[XB_TOPGEN], 1u);
      else XB_SPIN(xb_ld(&bar[XB_TOPGEN]) == tg, bar);
      __builtin_amdgcn_fence(__ATOMIC_ACQUIRE, "agent");
      xb_add(&bar[XB_XGEN(b.x)], 1u);
      asm volatile("s_waitcnt vmcnt(0)" ::: "memory");
    } else {
      XB_SPIN(xb_ld(&bar[XB_XGEN(b.x)]) == gen, bar);
      __builtin_amdgcn_fence(__ATOMIC_ACQUIRE, "agent");
      asm volatile("s_waitcnt vmcnt(0)" ::: "memory");
    }
  }
  __syncthreads();
}

DI void conv_tile(const float* __restrict__ W, int K, int N, bfu* __restrict__ Wt, int kt, int nt, int perm, float* T) {
  const int tid = tid_l();
  const int k0 = kt * 64, n0 = nt * 64;
  __syncthreads();
  {
    const int n4 = (tid & 15) * 4, kk = tid >> 4;
#pragma unroll
    for (int i = 0; i < 4; ++i) {
      const int k = kk + 16 * i;
      float4 v = make_float4(0.f, 0.f, 0.f, 0.f);
      if (n0 + n4 < N) v = *(const float4*)(W + (size_t)(k0 + k) * N + n0 + n4);
      *(float4*)(T + k * 68 + (n4 ^ (((k >> 3) & 7) << 2))) = v;
    }
  }
  __syncthreads();
  {
    const int k8 = (tid & 7) * 8;
    const int sw = ((k8 >> 3) & 7) << 2;
#pragma unroll
    for (int i = 0; i < 2; ++i) {
      const int n = (tid >> 3) + 32 * i;
      const int ng = n0 + n;
      if (ng < N) {
        float tv[8];
#pragma unroll
        for (int j = 0; j < 8; ++j) tv[j] = T[(k8 + j) * 68 + (n ^ sw)];
        const bf16x8 v = pack8(tv);
        int nd = ng;
        if (perm) {
          if (ng < DFF) nd = (ng >> 6) * 128 + ((ng >> 5) & 1) * 64 + (ng & 31);
          else { const int n2 = ng - DFF; nd = (n2 >> 6) * 128 + ((n2 >> 5) & 1) * 64 + 32 + (n2 & 31); }
        }
        *(bf16x8*)(Wt + (size_t)nd * K + k0 + k8) = v;
      }
    }
  }
}

DI void phase_convert_layer(const Params& P, int l, char* smem, int bid, int nb) {
  float* T = (float*)smem;
  const int j = l >> 1;
  const int n_in = (l & 1) ? 1536 : 3104;
  const int nt_in = (n_in + 63) / 64;
  const float* w_in = (l & 1) ? (P.w_in_c + (size_t)j * D * 1536) : (P.w_in_ab + (size_t)j * D * 3104);
  const int c0 = 256, c1 = c0 + 16 * 88, c2 = c1 + 44 * 16, c3 = c2 + 16 * nt_in;
  for (int it = bid; it < c3; it += nb) {
    if (it < c0) conv_tile(P.w_out + (size_t)l * D * D, D, D, P.wout_t, it / 16, it % 16, 0, T);
    else if (it < c1) { const int r = it - c0; conv_tile(P.w_up + (size_t)l * D * 2 * DFF, D, 2 * DFF, P.wup_t, r / 88, r % 88, 1, T); }
    else if (it < c2) { const int r = it - c1; conv_tile(P.w_down + (size_t)l * DFF * D, DFF, D, P.wdown_t, r / 16, r % 16, 0, T); }
    else { const int r = it - c2; conv_tile(w_in, D, n_in, P.win_t, r / nt_in, r % nt_in, 0, T); }
  }
}

DI void phase_modp(const Params& P, char* smem, int bid, int nb) {
  float* sv = (float*)smem;
  const int tid = tid_l();
  for (int it = bid; it < 4 * 32 * 6; it += nb) {
    const int l = it / 192, r = it % 192, ks = r / 6, nblk = r % 6;
    __syncthreads();
    if (tid < 160) {
      const int s = tid >> 5, k = ks * 32 + (tid & 31);
      const float cv = (s < 4) ? P.c[s * D + k] : P.c_ctx[k];
      sv[tid] = cv / (1.f + expf(-cv));
    }
    __syncthreads();
    const int n = nblk * 1024 + tid * 4;
    float4 acc[5];
#pragma unroll
    for (int s = 0; s < 5; ++s) acc[s] = make_float4(0.f, 0.f, 0.f, 0.f);
    const float* wp = P.w_mod + ((size_t)l * D + ks * 32) * 6144 + n;
#pragma unroll 8
    for (int k = 0; k < 32; ++k) {
      const float4 w = *(const float4*)(wp + (size_t)k * 6144);
#pragma unroll
      for (int s = 0; s < 5; ++s) {
        const float sc = sv[s * 32 + k];
        acc[s].x += sc * w.x; acc[s].y += sc * w.y; acc[s].z += sc * w.z; acc[s].w += sc * w.w;
      }
    }
#pragma unroll
    for (int s = 0; s < 5; ++s) *(float4*)(P.modp + ((size_t)(l * 32 + ks) * 5 + s) * 6144 + n) = acc[s];
  }
}

DI void phase_rope(const Params& P, int bid, int nb) {
  for (int idx = bid * 256 + tid_l(); idx < 4096 * 32; idx += nb * 256) {
    const int t = idx >> 5, i = idx & 31;
    const int row = t >> 6, col = t & 63;
    const int j = i & 15;
    const float inv = 1.0f / powf(10000.0f, (float)(2 * j) / 32.0f);
    const float ang = (float)((i < 16) ? row : col) * inv;
    P.rope[idx] = make_float2(cosf(ang), sinf(ang));
  }
}

DI void phase_modreduce(const Params& P, int bid, int nb) {
  for (int idx = bid * 256 + tid_l(); idx < 4 * 5 * 6144; idx += nb * 256) {
    const int l = idx / (5 * 6144), r = idx % (5 * 6144), s = r / 6144, n = r % 6144;
    float acc = P.b_mod[l * 6144 + n];
#pragma unroll
    for (int ks = 0; ks < 32; ++ks) acc += P.modp[((size_t)(l * 32 + ks) * 5 + s) * 6144 + n];
    P.mod[idx] = acc;
  }
}

DI void phase_rows0(const Params& P, int mode, int lat_only, const float* gpost, const float* modl_gate  ,
                   const float* gpre, const float* modl_shift, const float* modl_scale, int bid, int nb) {
  const int lane = tid_l() & 63;
  const int wid = bid * 4 + (tid_l() >> 6), nw = nb * 4;
  for (int m = wid; m < MTOT; m += nw) {
    const int b = m / PB, p = m % PB;
    if (lat_only && p < 256) continue;
    const int s = (p < 256) ? 4 : b;
    float4 v[4];
    if (mode == 0) {
      const float* src = (p < 256) ? (P.ctx + ((size_t)b * 256 + p) * D) : (P.x + ((size_t)b * 4096 + (p - 256)) * D);
#pragma unroll
      for (int i = 0; i < 4; ++i) v[i] = *(const float4*)(src + lane * 4 + 256 * i);
    } else {
      const float* xr = P.xres + (size_t)m * D;
      const float* yr = P.yo + (size_t)m * D;
      float4 yv[4];
      float ss = 0.f;
#pragma unroll
      for (int i = 0; i < 4; ++i) {
        v[i] = *(const float4*)(xr + lane * 4 + 256 * i);
        yv[i] = *(const float4*)(yr + lane * 4 + 256 * i);
        ss += yv[i].x * yv[i].x + yv[i].y * yv[i].y + yv[i].z * yv[i].z + yv[i].w * yv[i].w;
      }
      ss = wave_sum(ss);
      const float rs = rsqrtf(ss * (1.f / 1024.f) + EPSF);
      const float* gate = modl_gate + (size_t)s * 6144;
#pragma unroll
      for (int i = 0; i < 4; ++i) {
        const int e = lane * 4 + 256 * i;
        const float4 gp = *(const float4*)(gpost + e);
        const float4 gt = *(const float4*)(gate + e);
        v[i].x += gt.x * (yv[i].x * rs * gp.x);
        v[i].y += gt.y * (yv[i].y * rs * gp.y);
        v[i].z += gt.z * (yv[i].z * rs * gp.z);
        v[i].w += gt.w * (yv[i].w * rs * gp.w);
      }
    }
    if (mode == 2) {
      float* o = P.out + ((size_t)b * 4096 + (p - 256)) * D;
#pragma unroll
      for (int i = 0; i < 4; ++i) *(float4*)(o + lane * 4 + 256 * i) = v[i];
      continue;
    }
    {
      float* xr = P.xres + (size_t)m * D;
#pragma unroll
      for (int i = 0; i < 4; ++i) *(float4*)(xr + lane * 4 + 256 * i) = v[i];
    }
    float ss2 = 0.f;
#pragma unroll
    for (int i = 0; i < 4; ++i) ss2 += v[i].x * v[i].x + v[i].y * v[i].y + v[i].z * v[i].z + v[i].w * v[i].w;
    ss2 = wave_sum(ss2);
    const float rs2 = rsqrtf(ss2 * (1.f / 1024.f) + EPSF);
    const float* sh = modl_shift + (size_t)s * 6144;
    const float* sc = modl_scale + (size_t)s * 6144;
    bfu* hr = P.h + (size_t)m * D;
#pragma unroll
    for (int i = 0; i < 4; ++i) {
      const int e = lane * 4 + 256 * i;
      const float4 g = *(const float4*)(gpre + e);
      const float4 a = *(const float4*)(sh + e);
      const float4 c = *(const float4*)(sc + e);
      *(s16x4*)(hr + e) = pack4((v[i].x * rs2 * g.x) * (1.f + c.x) + a.x, (v[i].y * rs2 * g.y) * (1.f + c.y) + a.y,
                                (v[i].z * rs2 * g.z) * (1.f + c.z) + a.z, (v[i].w * rs2 * g.w) * (1.f + c.w) + a.w);
    }
  }
}

DI void phase_rows(const Params& P, int mode, int lat_only, const float* gpost, const float* modl_gate,
                   const float* gpre, const float* modl_shift, const float* modl_scale, int bid, int nb) {
  const int lane = tid_l() & 63;
  const int wid = bid * 4 + (tid_l() >> 6), nw = nb * 4;
  const int NR = lat_only ? 16384 : MTOT;
  float4 gp[4], gq[4];
#pragma unroll
  for (int i = 0; i < 4; ++i) {
    gp[i] = *(const float4*)(gpost + lane * 4 + 256 * i);
    gq[i] = (mode == 1) ? *(const float4*)(gpre + lane * 4 + 256 * i) : make_float4(0.f, 0.f, 0.f, 0.f);
  }
  float4 xv[4], yv[4], xn[4], yn[4];
  int ri = wid;
  if (ri < NR) {
    const int m = lat_only ? ((ri >> 12) * PB + 256 + (ri & 4095)) : ri;
#pragma unroll
    for (int i = 0; i < 4; ++i) {
      xv[i] = *(const float4*)(P.xres + (size_t)m * D + lane * 4 + 256 * i);
      const s16x4 yb = *(const s16x4*)((const bfu*)P.yo + (size_t)m * D + lane * 4 + 256 * i);
      yv[i] = make_float4(bf2f((bfu)yb[0]), bf2f((bfu)yb[1]), bf2f((bfu)yb[2]), bf2f((bfu)yb[3]));
    }
  }
  for (; ri < NR; ri += nw) {
    const int m = lat_only ? ((ri >> 12) * PB + 256 + (ri & 4095)) : ri;
    const int b = m / PB, p = m % PB;
    const int s = (p < 256) ? 4 : b;
    const int rn = ri + nw;
    if (rn < NR) {
      const int mn = lat_only ? ((rn >> 12) * PB + 256 + (rn & 4095)) : rn;
#pragma unroll
      for (int i = 0; i < 4; ++i) {
        xn[i] = *(const float4*)(P.xres + (size_t)mn * D + lane * 4 + 256 * i);
        const s16x4 yb = *(const s16x4*)((const bfu*)P.yo + (size_t)mn * D + lane * 4 + 256 * i);
        yn[i] = make_float4(bf2f((bfu)yb[0]), bf2f((bfu)yb[1]), bf2f((bfu)yb[2]), bf2f((bfu)yb[3]));
      }
    }
    const float* gate = modl_gate + (size_t)s * 6144;
    float4 gt[4], sh[4], sc[4];
#pragma unroll
    for (int i = 0; i < 4; ++i) gt[i] = *(const float4*)(gate + lane * 4 + 256 * i);
    if (mode == 1) {
#pragma unroll
      for (int i = 0; i < 4; ++i) {
        sh[i] = *(const float4*)(modl_shift + (size_t)s * 6144 + lane * 4 + 256 * i);
        sc[i] = *(const float4*)(modl_scale + (size_t)s * 6144 + lane * 4 + 256 * i);
      }
    }
    float ss = 0.f;
#pragma unroll
    for (int i = 0; i < 4; ++i) ss += yv[i].x * yv[i].x + yv[i].y * yv[i].y + yv[i].z * yv[i].z + yv[i].w * yv[i].w;
    ss = wave_sum(ss);
    const float rs = rsqrtf(ss * (1.f / 1024.f) + EPSF);
    float4 v[4];
#pragma unroll
    for (int i = 0; i < 4; ++i) {
      v[i].x = xv[i].x + gt[i].x * (yv[i].x * rs * gp[i].x);
      v[i].y = xv[i].y + gt[i].y * (yv[i].y * rs * gp[i].y);
      v[i].z = xv[i].z + gt[i].z * (yv[i].z * rs * gp[i].z);
      v[i].w = xv[i].w + gt[i].w * (yv[i].w * rs * gp[i].w);
    }
    if (mode == 2) {
      float* o = P.out + ((size_t)b * 4096 + (p - 256)) * D;
#pragma unroll
      for (int i = 0; i < 4; ++i) *(float4*)(o + lane * 4 + 256 * i) = v[i];
    } else {
      float* xr = P.xres + (size_t)m * D;
#pragma unroll
      for (int i = 0; i < 4; ++i) *(float4*)(xr + lane * 4 + 256 * i) = v[i];
      float ss2 = 0.f;
#pragma unroll
      for (int i = 0; i < 4; ++i) ss2 += v[i].x * v[i].x + v[i].y * v[i].y + v[i].z * v[i].z + v[i].w * v[i].w;
      ss2 = wave_sum(ss2);
      const float rs2 = rsqrtf(ss2 * (1.f / 1024.f) + EPSF);
      bfu* hr = P.h + (size_t)m * D;
#pragma unroll
      for (int i = 0; i < 4; ++i) {
        const int e = lane * 4 + 256 * i;
        *(s16x4*)(hr + e) = pack4((v[i].x * rs2 * gq[i].x) * (1.f + sc[i].x) + sh[i].x, (v[i].y * rs2 * gq[i].y) * (1.f + sc[i].y) + sh[i].y,
                                  (v[i].z * rs2 * gq[i].z) * (1.f + sc[i].z) + sh[i].z, (v[i].w * rs2 * gq[i].w) * (1.f + sc[i].w) + sh[i].w);
      }
    }
#pragma unroll
    for (int i = 0; i < 4; ++i) { xv[i] = xn[i]; yv[i] = yn[i]; }
  }
}

template <bool TR>
DI void gemm_main(const bfu* __restrict__ A, const bfu* __restrict__ Bt, int K, int m0, int n0, char* smem, f32x16 (&acc)[2][2]) {
  const int tid = tid_l(), lane = tid & 63, w = tid >> 6, wm = w & 1, wn = w >> 1;
  const int lr = lane & 31, lh = lane >> 5;
#pragma unroll
  for (int i = 0; i < 2; ++i)
#pragma unroll
    for (int j = 0; j < 2; ++j)
#pragma unroll
      for (int r = 0; r < 16; ++r) acc[i][j][r] = 0.f;
  const int lrow = tid >> 3, lchunk = tid & 7;
  const bfu* ga = A + (size_t)(m0 + lrow) * K + lchunk * 8;
  const bfu* gb = Bt + (size_t)(n0 + lrow) * K + lchunk * 8;
  const size_t rs32 = (size_t)32 * K;
  char* st_w = smem + lrow * 128 + ((lchunk ^ ((lrow >> 1) & 7)) << 4);
  const int s7 = (lr >> 1) & 7;
  const char* rd_a = smem + (wm * 64 + lr) * 128;
  const char* rd_b = smem + 16384 + (wn * 64 + lr) * 128;
  int off[4];
#pragma unroll
  for (int ks = 0; ks < 4; ++ks) off[ks] = ((ks * 2 + lh) ^ s7) << 4;
  u32x4 ra[4], rb[4];
#define GLOAD1(I, KOFF) { ra[I] = *(const u32x4*)(ga + (I) * rs32 + (KOFF)); rb[I] = *(const u32x4*)(gb + (I) * rs32 + (KOFF)); }
#define LSTORE1(I, STG) { *(u32x4*)(st_w + (STG) * 32768 + (I) * 4096) = ra[I]; *(u32x4*)(st_w + (STG) * 32768 + 16384 + (I) * 4096) = rb[I]; }
#define FREAD(AF, BF, STG, KS)                                      \
  _Pragma("unroll") for (int i = 0; i < 2; ++i) AF[i] = *(const bf16x8*)(rd_a + (STG) * 32768 + i * 4096 + off[KS]);  \
  _Pragma("unroll") for (int j = 0; j < 2; ++j) BF[j] = *(const bf16x8*)(rd_b + (STG) * 32768 + j * 4096 + off[KS]);
#define MMA4(AF, BF)                                                \
  _Pragma("unroll") for (int i = 0; i < 2; ++i)                     \
    _Pragma("unroll") for (int j = 0; j < 2; ++j) acc[i][j] = TR ? MFMA(BF[j], AF[i], acc[i][j]) : MFMA(AF[i], BF[j], acc[i][j]);
#define SB __builtin_amdgcn_sched_barrier(0);
#define GLA_(I, KOFF) { ra[I] = *(const u32x4*)(ga + (I) * rs32 + (KOFF)); }
#define GLB_(I, KOFF) { rb[I] = *(const u32x4*)(gb + (I) * rs32 + (KOFF)); }
#define LSA_(I, STG) { *(u32x4*)(st_w + (STG) * 32768 + (I) * 4096) = ra[I]; }
#define LSB_(I, STG) { *(u32x4*)(st_w + (STG) * 32768 + 16384 + (I) * 4096) = rb[I]; }
#define MMA2(AF, BF, I) _Pragma("unroll") for (int j = 0; j < 2; ++j) acc[I][j] = TR ? MFMA(BF[j], AF[I], acc[I][j]) : MFMA(AF[I], BF[j], acc[I][j]);
#define PIECE(P_, RS, DOST, DOLD, KOFF, AF, BF)                     \
    if (DOST) LSA_(P_, 1 - (RS)) if (DOLD) GLA_(P_, KOFF)           \
    SB                                                              \
    MMA2(AF, BF, 0)                                                 \
    SB                                                              \
    if (DOST) LSB_(P_, 1 - (RS)) if (DOLD) GLB_(P_, KOFF)           \
    SB                                                              \
    MMA2(AF, BF, 1)                                                 \
    SB
#define STEP(RS, DOST, DOLD, KOFF) {                                \
    bf16x8 fa0[2], fb0[2], fa1[2], fb1[2];                          \
    FREAD(fa0, fb0, RS, 0)                                          \
    FREAD(fa1, fb1, RS, 1)                                          \
    SB                                                              \
    PIECE(0, RS, DOST, DOLD, KOFF, fa0, fb0)                        \
    FREAD(fa0, fb0, RS, 2)                                          \
    PIECE(1, RS, DOST, DOLD, KOFF, fa1, fb1)                        \
    FREAD(fa1, fb1, RS, 3)                                          \
    PIECE(2, RS, DOST, DOLD, KOFF, fa0, fb0)                        \
    PIECE(3, RS, DOST, DOLD, KOFF, fa1, fb1)                        \
  }
#pragma unroll
  for (int i = 0; i < 4; ++i) GLOAD1(i, 0)
  __syncthreads();
#pragma unroll
  for (int i = 0; i < 4; ++i) LSTORE1(i, 0)
#pragma unroll
  for (int i = 0; i < 4; ++i) GLOAD1(i, 64)
  __syncthreads();
  for (int k0 = 0; k0 < K; k0 += 128) {
    const bool more1 = k0 + 128 < K, more2 = k0 + 192 < K;
    STEP(0, true, more1, k0 + 128)
    __syncthreads();
    STEP(1, more1, more2, k0 + 192)
    __syncthreads();
  }
#undef GLOAD1
#undef LSTORE1
#undef FREAD
#undef MMA4
#undef STEP
#undef SB
}

DI u32x4 merge_groups(u32x2 a, u32x2 b) {
  const u32x2 r0 = __builtin_amdgcn_permlane32_swap(a[0], b[0], false, false);
  const u32x2 r1 = __builtin_amdgcn_permlane32_swap(a[1], b[1], false, false);
  u32x4 o; o[0] = r0[0]; o[1] = r1[0]; o[2] = r0[1]; o[3] = r1[1];
  return o;
}
DI u32x2 pack4u(float a, float b, float c, float d) { u32x2 r; r[0] = pk_bf16(a, b); r[1] = pk_bf16(c, d); return r; }

DI int map_mtile(int idx, int lat_only) {
  if (!lat_only) return idx;
  return (idx >> 5) * 34 + 2 + (idx & 31);
}

DI bool gemm_tile_map(int it, int bid, int nb, int MT, int NT, int& mi, int& ni) {
  const int T = MT * NT, full = T / nb;
  int L;
  if (it < full && (nb & 7) == 0) { const int nloc = nb >> 3; L = (it * 8 + (bid & 7)) * nloc + (bid >> 3); }
  else L = it * nb + bid;
  if (L >= T) return false;
  const int sr = L / (8 * NT), rem = L % (8 * NT);
  ni = rem >> 3;
  mi = sr * 8 + (rem & 7);
  return true;
}

DI void phase_gemm_f32(const Params& P, const bfu* A, const bfu* Bt, int K, int N, bfu* C, int lat_only, char* smem, int bid, int nb) {
  const int NT = N / 128, MT = lat_only ? 128 : 136;
  const int lane = tid_l() & 63, w = tid_l() >> 6, wm = w & 1, wn = w >> 1, lr = lane & 31, lh = lane >> 5;
  for (int it = 0;; ++it) {
    int mi_, ni_;
    if (!gemm_tile_map(it, bid, nb, MT, NT, mi_, ni_)) break;
    const int m0 = map_mtile(mi_, lat_only) * 128, n0 = ni_ * 128;
    f32x16 acc[2][2];
    gemm_main<true>(A, Bt, K, m0, n0, smem, acc);
#pragma unroll
    for (int i = 0; i < 2; ++i) {
      const int m = m0 + wm * 64 + i * 32 + lr;
#pragma unroll
      for (int j = 0; j < 2; ++j)
#pragma unroll
        for (int gp = 0; gp < 4; gp += 2) {
          const u32x4 v = merge_groups(pack4u(acc[i][j][4 * gp], acc[i][j][4 * gp + 1], acc[i][j][4 * gp + 2], acc[i][j][4 * gp + 3]),
                                       pack4u(acc[i][j][4 * gp + 4], acc[i][j][4 * gp + 5], acc[i][j][4 * gp + 6], acc[i][j][4 * gp + 7]));
          *(u32x4*)(C + (size_t)m * N + n0 + wn * 64 + j * 32 + 8 * (gp + lh)) = v;
        }
    }
  }
}

DI void phase_gemm_inab(const Params& P, char* smem, int bid, int nb) {
  const int NT = 25, MT = 136;
  const int lane = tid_l() & 63, w = tid_l() >> 6, wm = w & 1, wn = w >> 1, lr = lane & 31, lh = lane >> 5;
  for (int it = 0;; ++it) {
    int mi_, ni_;
    if (!gemm_tile_map(it, bid, nb, MT, NT, mi_, ni_)) break;
    const int m0 = mi_ * 128, n0 = ni_ * 128;
    f32x16 acc[2][2];
    const bool vtile = (ni_ >= 8 && ni_ < 12) || (ni_ >= 16 && ni_ < 20);
    if (vtile) {
      gemm_main<false>(P.h, P.win_t, D, m0, n0, smem, acc);
#pragma unroll
      for (int i = 0; i < 2; ++i)
#pragma unroll
        for (int j = 0; j < 2; ++j) {
          const int nbase = n0 + wn * 64 + j * 32;
          const int n = nbase + lr;
#pragma unroll
          for (int g = 0; g < 4; ++g) {
            const int m = m0 + wm * 64 + i * 32 + g * 8 + lh * 4;
            const int b = m / PB, p = m % PB;
            const float v0 = acc[i][j][g * 4 + 0], v1 = acc[i][j][g * 4 + 1], v2 = acc[i][j][g * 4 + 2], v3 = acc[i][j][g * 4 + 3];
            if (nbase < 1536) {
              const int nn = n - 1024, head = nn >> 6, d = nn & 63;
              *(s16x4*)(P.vaT + (size_t)(b * 8 + head) * PB * 64 + v_off(p, d)) = pack4(v0, v1, v2, v3);
            } else {
              const int nn = n - 2048, head = nn >> 7, dv = nn & 127;
              *(s16x4*)(P.vbT + ((size_t)(b * 4 + head) * 128 + dv) * PB + p) = pack4(v0, v1, v2, v3);
            }
          }
        }
    } else {
      gemm_main<true>(P.h, P.win_t, D, m0, n0, smem, acc);
#pragma unroll
      for (int i = 0; i < 2; ++i) {
        const int m = m0 + wm * 64 + i * 32 + lr;
        const int b = m / PB, p = m % PB;
#pragma unroll
        for (int j = 0; j < 2; ++j) {
          const int nbase = n0 + wn * 64 + j * 32;
          if (nbase >= 3104) continue;
          if (nbase >= 3072) {
#pragma unroll
            for (int g = 0; g < 4; ++g) {
              float4 zv = make_float4(acc[i][j][4 * g], acc[i][j][4 * g + 1], acc[i][j][4 * g + 2], acc[i][j][4 * g + 3]);
              *(float4*)(P.z + (size_t)m * 32 + (nbase - 3072) + 8 * g + 4 * lh) = zv;
            }
            continue;
          }
          const float sc = (nbase >= 1536 && nbase < 1792) ? 0.125f : 1.f;
#pragma unroll
          for (int gp = 0; gp < 4; gp += 2) {
            const u32x4 v = merge_groups(pack4u(acc[i][j][4 * gp] * sc, acc[i][j][4 * gp + 1] * sc, acc[i][j][4 * gp + 2] * sc, acc[i][j][4 * gp + 3] * sc),
                                         pack4u(acc[i][j][4 * gp + 4] * sc, acc[i][j][4 * gp + 5] * sc, acc[i][j][4 * gp + 6] * sc, acc[i][j][4 * gp + 7] * sc));
            const int col = nbase + 8 * (gp + lh);
            bfu* dst;
            if (nbase < 1024) {
              const int which = nbase >> 9;
              const int nn = col - which * 512, head = nn >> 6, d = nn & 63;
              dst = (which == 0 ? P.qa : P.ka) + (size_t)(b * 8 + head) * PB * 64 + kq_off(p, d);
            } else if (nbase < 2048) {
              const int which = (nbase - 1536) >> 8;
              const int nn = col - 1536 - which * 256, head = nn >> 6, d = nn & 63;
              dst = (which == 0 ? P.qb : P.kb) + ((size_t)(b * 4 + head) * PB + p) * 64 + d;
            } else {
              dst = P.rb + (size_t)m * 512 + (col - 2560);
            }
            *(u32x4*)dst = v;
          }
        }
      }
    }
  }
}

DI void phase_gemm_inc(const Params& P, char* smem, int bid, int nb) {
  const int NT = 12, MT = 136;
  const int lane = tid_l() & 63, w = tid_l() >> 6, wm = w & 1, wn = w >> 1, lr = lane & 31, lh = lane >> 5;
  bfu* Q = P.qa;
  bfu* Kk = P.qa + (size_t)MTOT * 1024;
  bfu* Vt = Kk + (size_t)MTOT * 256;
  for (int it = 0;; ++it) {
    int mi_, ni_;
    if (!gemm_tile_map(it, bid, nb, MT, NT, mi_, ni_)) break;
    const int m0 = mi_ * 128, n0 = ni_ * 128;
    f32x16 acc[2][2];
    if (ni_ >= 10) {
      gemm_main<false>(P.h, P.win_t, D, m0, n0, smem, acc);
#pragma unroll
      for (int i = 0; i < 2; ++i)
#pragma unroll
        for (int j = 0; j < 2; ++j) {
          const int n = n0 + wn * 64 + j * 32 + lr;
#pragma unroll
          for (int g = 0; g < 4; ++g) {
            const int m = m0 + wm * 64 + i * 32 + g * 8 + lh * 4;
            const int b = m / PB, p = m % PB;
            const int nn = n - 1280, head = nn >> 6, d = nn & 63;
            *(s16x4*)(Vt + (size_t)(b * 4 + head) * PB * 64 + v_off(p, d)) = pack4(acc[i][j][g * 4], acc[i][j][g * 4 + 1], acc[i][j][g * 4 + 2], acc[i][j][g * 4 + 3]);
          }
        }
    } else {
      gemm_main<true>(P.h, P.win_t, D, m0, n0, smem, acc);
#pragma unroll
      for (int i = 0; i < 2; ++i) {
        const int m = m0 + wm * 64 + i * 32 + lr;
        const int b = m / PB, p = m % PB;
        const bool lat = p >= 256;
        const float4* rp = (const float4*)(P.rope + (size_t)(lat ? p - 256 : 0) * 32);
#pragma unroll
        for (int j = 0; j < 2; ++j) {
          const int nbase = n0 + wn * 64 + j * 32;
          float v[16];
#pragma unroll
          for (int g = 0; g < 4; ++g) {
            const int d4 = ((nbase & 63) + 8 * g + 4 * lh) >> 2;
            const float4 cs = rp[d4];
            const float x0 = acc[i][j][4 * g], x1 = acc[i][j][4 * g + 1], x2 = acc[i][j][4 * g + 2], x3 = acc[i][j][4 * g + 3];
            v[4 * g + 0] = lat ? (x0 * cs.x - x1 * cs.y) : x0;
            v[4 * g + 1] = lat ? (x0 * cs.y + x1 * cs.x) : x1;
            v[4 * g + 2] = lat ? (x2 * cs.z - x3 * cs.w) : x2;
            v[4 * g + 3] = lat ? (x2 * cs.w + x3 * cs.z) : x3;
          }
#pragma unroll
          for (int gp = 0; gp < 4; gp += 2) {
            const u32x4 pv = merge_groups(pack4u(v[4 * gp], v[4 * gp + 1], v[4 * gp + 2], v[4 * gp + 3]),
                                          pack4u(v[4 * gp + 4], v[4 * gp + 5], v[4 * gp + 6], v[4 * gp + 7]));
            const int col = nbase + 8 * (gp + lh);
            bfu* dst;
            if (nbase < 1024) dst = Q + (size_t)(b * 16 + (col >> 6)) * PB * 64 + kq_off(p, col & 63);
            else dst = Kk + (size_t)(b * 4 + ((col - 1024) >> 6)) * PB * 64 + kq_off(p, col & 63);
            *(u32x4*)dst = pv;
          }
        }
      }
    }
  }
}

DI float dpp_x1(float v) { return __int_as_float(__builtin_amdgcn_update_dpp(0, __float_as_int(v), 0xB1, 0xf, 0xf, false)); }
DI float dpp_x2(float v) { return __int_as_float(__builtin_amdgcn_update_dpp(0, __float_as_int(v), 0x4E, 0xf, 0xf, false)); }
DI void phase_gemm_wup(const Params& P, int l, int lat_only, char* smem, int bid, int nb) {
  const int NT = 44, MT = lat_only ? 128 : 136;
  const int tid = tid_l(), lane = tid & 63, w = tid >> 6, wm = w & 1, wn = w >> 1, lr = lane & 31, lh = lane >> 5;
  const float* cw = P.conv_w + (size_t)l * 3 * 2 * DFF;
  const float* cb = P.conv_b + (size_t)l * 2 * DFF;
  for (int it = 0;; ++it) {
    int mi_, ni_;
    if (!gemm_tile_map(it, bid, nb, MT, NT, mi_, ni_)) break;
    const int mt = map_mtile(mi_, lat_only), nt = ni_;
    const int m0 = mt * 128, n0 = nt * 128;
    f32x16 acc[2][2];
    gemm_main<false>(P.h, P.wup_t, D, m0, n0, smem, acc);
    const int ch = nt * 64 + wn * 32 + lr;
    const float g0 = cw[ch], g1 = cw[2 * DFF + ch], g2 = cw[4 * DFF + ch], gb = cb[ch];
    const float u0 = cw[DFF + ch], u1 = cw[3 * DFF + ch], u2 = cw[5 * DFF + ch], ubb = cb[DFF + ch];
    float XG[2][4], YG[2][4], XV[2][4], YV[2][4];
#pragma unroll
    for (int i = 0; i < 2; ++i)
#pragma unroll
      for (int g = 0; g < 4; ++g) {
        XG[i][g] = __shfl_xor(acc[i][0][4 * g + 3], 32);
        YG[i][g] = __shfl_xor(acc[i][0][4 * g + 0], 32);
        XV[i][g] = __shfl_xor(acc[i][1][4 * g + 3], 32);
        YV[i][g] = __shfl_xor(acc[i][1][4 * g + 0], 32);
      }
    const int u64 = mt * 2 + wm;
    float* ubp = P.ub + ((size_t)u64 * 4 * DFF + ch) * 2;
#pragma unroll
    for (int i = 0; i < 2; ++i)
#pragma unroll
      for (int g = 0; g < 4; ++g) {
        const float pG = lh ? XG[i][g] : (g > 0 ? XG[i][g - 1] : (i > 0 ? XG[0][3] : 0.f));
        const float pV = lh ? XV[i][g] : (g > 0 ? XV[i][g - 1] : (i > 0 ? XV[0][3] : 0.f));
        const float nG = lh ? (g < 3 ? YG[i][g + 1] : (i < 1 ? YG[1][0] : 0.f)) : YG[i][g];
        const float nV = lh ? (g < 3 ? YV[i][g + 1] : (i < 1 ? YV[1][0] : 0.f)) : YV[i][g];
        float out[4];
#pragma unroll
        for (int q = 0; q < 4; ++q) {
          const float cG = acc[i][0][4 * g + q], cV = acc[i][1][4 * g + q];
          const float lG = q > 0 ? acc[i][0][4 * g + q - 1] : pG, lV = q > 0 ? acc[i][1][4 * g + q - 1] : pV;
          const float rG = q < 3 ? acc[i][0][4 * g + q + 1] : nG, rV = q < 3 ? acc[i][1][4 * g + q + 1] : nV;
          const float gg = g0 * lG + g1 * cG + g2 * rG + gb;
          const float vv = u0 * lV + u1 * cV + u2 * rV + ubb;
          out[q] = siluf(gg) * vv;
        }
        const int rl = i * 32 + 8 * g + 4 * lh;
        {
          const bool b0 = lr & 1, b1 = (lr >> 1) & 1;
          const float r01 = dpp_x1(b0 ? out[0] : out[1]), r23 = dpp_x1(b0 ? out[2] : out[3]);
          const float n0 = b0 ? r01 : out[0], n1 = b0 ? out[1] : r01, n2 = b0 ? r23 : out[2], n3 = b0 ? out[3] : r23;
          const float ra = dpp_x2(b1 ? n0 : n2), rb2 = dpp_x2(b1 ? n1 : n3);
          const float f0 = b1 ? ra : n0, f1 = b1 ? rb2 : n1, f2 = b1 ? n2 : ra, f3 = b1 ? n3 : rb2;
          const int rq = lr & 3;
          const bool first = (i == 0 && g == 0) && (lh == 0) && (rq == 0);
          const bool last = (i == 1 && g == 3) && (lh == 1) && (rq == 3);
          bfu* ap = P.a + (size_t)(m0 + wm * 64 + rl + rq) * DFF + (ch - rq);
          if (!first && !last) *(s16x4*)ap = pack4(f0, f1, f2, f3);
        }
        if (i == 0 && g == 0) {
          if (lh == 0) {
            ubp[0] = acc[0][0][0]; ubp[1] = acc[0][1][0];
            ubp[(size_t)DFF * 2] = acc[0][0][1]; ubp[(size_t)DFF * 2 + 1] = acc[0][1][1];
          }
        }
        if (i == 1 && g == 3) {
          if (lh == 1) {
            ubp[(size_t)2 * DFF * 2] = acc[1][0][14]; ubp[(size_t)2 * DFF * 2 + 1] = acc[1][1][14];
            ubp[(size_t)3 * DFF * 2] = acc[1][0][15]; ubp[(size_t)3 * DFF * 2 + 1] = acc[1][1][15];
          }
        }
      }
  }
}

DI void phase_fix(const Params& P, int l, int lat_only, int bid, int nb) {
  const float* cw = P.conv_w + (size_t)l * 3 * 2 * DFF;
  const float* cb = P.conv_b + (size_t)l * 2 * DFF;
  const int total = 272 * 2 * DFF;
  for (int idx = bid * 256 + tid_l(); idx < total; idx += nb * 256) {
    const int ch = idx % DFF, rr = idx / DFF, which = rr & 1, u = rr >> 1;
    if (lat_only && (u % 68) < 4) continue;
    const int m = u * 64 + (which ? 63 : 0);
    const int p = m % PB;
    const float2* U = (const float2*)P.ub;
    auto ld = [&](int uu, int w4) { return U[(size_t)(uu * 4 + w4) * DFF + ch]; };
    float2 L = make_float2(0.f, 0.f), C, R = make_float2(0.f, 0.f);
    if (which == 0) {
      if ((p != 0) && (p != 256)) L = ld(u - 1, 3);
      C = ld(u, 0);
      R = ld(u, 1);
    } else {
      L = ld(u, 2);
      C = ld(u, 3);
      if ((p != 255) && (p != PB - 1)) R = ld(u + 1, 0);
    }
    const float gg = cw[ch] * L.x + cw[2 * DFF + ch] * C.x + cw[4 * DFF + ch] * R.x + cb[ch];
    const float vv = cw[DFF + ch] * L.y + cw[3 * DFF + ch] * C.y + cw[5 * DFF + ch] * R.y + cb[DFF + ch];
    P.a[(size_t)m * DFF + ch] = f2bf(siluf(gg) * vv);
  }
}

struct AttnState { f32x16 o0, o1; float m, l; };
struct KFrag { bf16x8 k[4]; };
struct VFrag { bf16x8 v[4]; };

DI void attn_init(AttnState& st, float m0, float l0) {
#pragma unroll
  for (int r = 0; r < 16; ++r) { st.o0[r] = 0.f; st.o1[r] = 0.f; }
  st.m = m0; st.l = l0;
}
DI void attn_qload(const bfu* Qblk, int lr, int lh, bf16x8 (&qf)[4]) {
#pragma unroll
  for (int ks = 0; ks < 4; ++ks) qf[ks] = *(const bf16x8*)(Qblk + ks * 512 + (lh * 32 + lr) * 8);
}
DI void attn_kload(KFrag& kf, const bfu* Kblk, int lr, int lh) {
#pragma unroll
  for (int ks = 0; ks < 4; ++ks) kf.k[ks] = *(const bf16x8*)(Kblk + ks * 512 + (lh * 32 + lr) * 8);
}
DI void attn_vload(VFrag& vf, const bfu* Vblk, int lr, int lh) {
#pragma unroll
  for (int q = 0; q < 4; ++q) vf.v[q] = *(const bf16x8*)(Vblk + q * 512 + (lh * 32 + lr) * 8);
}
DI f32x16 attn_scores(const KFrag& kf, const bf16x8 (&qf)[4]) {
  f32x16 s;
#pragma unroll
  for (int r = 0; r < 16; ++r) s[r] = 0.f;
#pragma unroll
  for (int ks = 0; ks < 4; ++ks) s = MFMA(kf.k[ks], qf[ks], s);
  return s;
}
DI void attn_update(AttnState& st, const f32x16& x, const VFrag& vf, float sc) {
  float mx = x[0];
#pragma unroll
  for (int r = 1; r < 16; ++r) mx = fmaxf(mx, x[r]);
  mx = fmaxf(mx, __shfl_xor(mx, 32)) * sc;
  float mn = st.m;
  if (__builtin_amdgcn_ballot_w64(mx > st.m + 8.f) != 0ull) {
    mn = fmaxf(st.m, mx);
    const float alpha = __builtin_amdgcn_exp2f(st.m - mn);
    st.l *= alpha;
#pragma unroll
    for (int r = 0; r < 16; ++r) { st.o0[r] *= alpha; st.o1[r] *= alpha; }
    st.m = mn;
  }
  float p[16];
  f2_t rs2 = {0.f, 0.f};
  const f2_t sc2 = {sc, sc}, nm2 = {-mn, -mn};
#pragma unroll
  for (int r = 0; r < 16; r += 2) {
    const f2_t xv = {x[r], x[r + 1]};
    const f2_t a = __builtin_elementwise_fma(xv, sc2, nm2);
    p[r] = __builtin_amdgcn_exp2f(a[0]); p[r + 1] = __builtin_amdgcn_exp2f(a[1]);
    const f2_t pv = {p[r], p[r + 1]};
    rs2 += pv;
  }
  float rs = rs2[0] + rs2[1];
  rs += __shfl_xor(rs, 32);
  st.l += rs;
#pragma unroll
  for (int s = 0; s < 2; ++s) {
    const bf16x8 pf = pack8(p + 8 * s);
    st.o0 = MFMA(vf.v[s * 2 + 0], pf, st.o0);
    st.o1 = MFMA(vf.v[s * 2 + 1], pf, st.o1);
  }
}
DI void attn_store(const AttnState& st, bfu* Y, int lr, int lh) {
  const float inv = 1.f / st.l;
#pragma unroll
  for (int g = 0; g < 4; ++g) {
    const int d = 8 * g + 4 * lh;
    *(s16x4*)(Y + (size_t)lr * D + d) = pack4(st.o0[4 * g] * inv, st.o0[4 * g + 1] * inv, st.o0[4 * g + 2] * inv, st.o0[4 * g + 3] * inv);
    *(s16x4*)(Y + (size_t)lr * D + 32 + d) = pack4(st.o1[4 * g] * inv, st.o1[4 * g + 1] * inv, st.o1[4 * g + 2] * inv, st.o1[4 * g + 3] * inv);
  }
}
template <class KP, class MF>
DI void attn_run(AttnState& st, const bf16x8 (&qf)[4], const bfu* Kbase, const bfu* Vbase, int nblk, int lr, int lh, KP keypos, MF maskf) {
  KFrag kf;
  attn_kload(kf, Kbase + (size_t)keypos(0) * 64, lr, lh);
  for (int jb = 0; jb < nblk; ++jb) {
    VFrag vf;
    attn_vload(vf, Vbase + (size_t)keypos(jb) * 64, lr, lh);
    KFrag kn;
    const int jn = jb + 1 < nblk ? jb + 1 : jb;
    attn_kload(kn, Kbase + (size_t)keypos(jn) * 64, lr, lh);
    f32x16 s = attn_scores(kf, qf);
    const float sc = maskf(jb, s);
    attn_update(st, s, vf, sc);
    kf = kn;
  }
}

DI void phase_na(const Params& P, int jl, char* smem, int bid, int nb) {
  const int lane = tid_l() & 63, w = tid_l() >> 6, lr = lane & 31, lh = lane >> 5;
  float* rpb = (float*)smem + 64;
  __syncthreads();
  for (int i = tid_l(); i < 8 * 15 * 31; i += 256) rpb[i] = P.na_rpb[(size_t)jl * 8 * 15 * 31 + i] * LOG2E;
  __syncthreads();
  const int n_lat = 4 * 64 * 4, n_ctx = 4 * 8 * 2;
  for (int kk = 0;; ++kk) {
    const int it = ((nb & 7) == 0 && kk < (n_lat + n_ctx) / nb) ? ((kk * 8 + (bid & 7)) * (nb >> 3) + (bid >> 3)) : (kk * nb + bid);
    if (it >= n_lat + n_ctx) break;
    AttnState st;
    attn_init(st, NEGF, 0.f);
    bf16x8 qf[4];
    if (it < n_lat) {
      const int b = it >> 8, hp = (it >> 6) & 3, r = it & 63;
      const int head = hp * 2 + (w >> 1), qblk = w & 1;
      const size_t bh = (size_t)(b * 8 + head);
      const int pq = 256 + r * 64 + qblk * 32;
      attn_qload(P.qa + (bh * PB + pq) * 64, lr, lh, qf);
      const bfu* Kbase = P.ka + bh * PB * 64;
      const bfu* Vbase = P.vaT + bh * 64 * PB;
      int rstart = r - 4; rstart = rstart < 0 ? 0 : (rstart > 56 ? 56 : rstart);
      const int cq = qblk * 32 + lr;
      int cs = cq - 8; cs = cs < 0 ? 0 : (cs > 48 ? 48 : cs);
      unsigned mask0 = 0u, mask1 = 0u;
#pragma unroll
      for (int q = 0; q < 16; ++q) {
        const int k0c = crow(q, lh), k1c = 32 + crow(q, lh);
        mask0 |= ((k0c >= cs) && (k0c < cs + 16)) ? (1u << q) : 0u;
        mask1 |= ((k1c >= cs) && (k1c < cs + 16)) ? (1u << q) : 0u;
      }
      const int dcb0 = 0 - cq + 15 + 4 * lh, dcb1 = 32 - cq + 15 + 4 * lh;
      attn_run(st, qf, Kbase, Vbase, 24, lr, lh,
               [&](int jb) { return jb < 8 ? jb * 32 : 256 + (rstart + ((jb - 8) >> 1)) * 64 + ((jb - 8) & 1) * 32; },
               [&](int jb, f32x16& s) {
                 if (jb < 8) return QSCALE;
                 const int j = jb - 8, rr = j >> 1, par = j & 1;
                 const int dr = rstart + rr - r + 7;
                 const unsigned msk = par ? mask1 : mask0;
                 const float* bp = rpb + (head * 15 + dr) * 31 + (par ? dcb1 : dcb0);
#pragma unroll
                 for (int q = 0; q < 16; ++q) {
                   const float bias = bp[(q & 3) + 8 * (q >> 2)];
                   s[q] = ((msk >> q) & 1u) ? fmaf(s[q], QSCALE, bias) : NEGF;
                 }
                 return 1.f;
               });
      attn_store(st, P.y + ((size_t)b * PB + pq) * D + head * 64, lr, lh);
    } else {
      const int r2 = it - n_lat;
      const int b = r2 >> 4, head = (r2 >> 1) & 7, half = r2 & 1;
      const int qblk = half * 4 + w;
      const size_t bh = (size_t)(b * 8 + head);
      attn_qload(P.qa + (bh * PB + qblk * 32) * 64, lr, lh, qf);
      attn_run(st, qf, P.ka + bh * PB * 64, P.vaT + bh * 64 * PB, 8, lr, lh,
               [&](int jb) { return jb * 32; },
               [&](int jb, f32x16& s) {
                 return QSCALE;
               });
      attn_store(st, P.y + ((size_t)b * PB + qblk * 32) * D + head * 64, lr, lh);
    }
  }
}

DI void phase_swa(const Params& P, int jl, int need_ctx, int bid, int nb) {
  const int lane = tid_l() & 63, w = tid_l() >> 6, lr = lane & 31, lh = lane >> 5;
  const bfu* Q = P.qa;
  const bfu* Kk = P.qa + (size_t)MTOT * 1024;
  const bfu* Vt = Kk + (size_t)MTOT * 256;
  const float* sink = P.swa_sink + jl * 16;
  const int n_lat = 4 * 16 * 32, n_ctx = need_ctx ? 4 * 16 * 2 : 0;
  for (int kk = 0;; ++kk) {
    const int it = ((nb & 7) == 0 && kk < (n_lat + n_ctx) / nb) ? ((kk * 8 + (bid & 7)) * (nb >> 3) + (bid >> 3)) : (kk * nb + bid);
    if (it >= n_lat + n_ctx) break;
    AttnState st;
    bf16x8 qf[4];
    if (it < n_lat) {
      const int b = it >> 9, hq = (it >> 5) & 15, tb = (it & 31) * 4 + w;
      const int kvh = hq >> 2;
      attn_init(st, sink[hq] * LOG2E, 1.f);
      const int pq = 256 + tb * 32;
      attn_qload(Q + ((size_t)(b * 16 + hq) * PB + pq) * 64, lr, lh, qf);
      const bfu* Kbase = Kk + (size_t)(b * 4 + kvh) * PB * 64;
      const bfu* Vbase = Vt + (size_t)(b * 4 + kvh) * 64 * PB;
      const int k_lo = tb - 4 < 0 ? 0 : tb - 4, k_hi = tb + 4 > 127 ? 127 : tb + 4;
      const int tq = tb * 32 + lr;
      attn_run(st, qf, Kbase, Vbase, 8 + (k_hi - k_lo + 1), lr, lh,
               [&](int jb) { return jb < 8 ? jb * 32 : 256 + (k_lo + jb - 8) * 32; },
               [&](int jb, f32x16& s) {
                 const int kb = k_lo + jb - 8;
                 if (jb < 8 || (kb > tb - 4 && kb < tb + 4)) return QSCALE;
#pragma unroll
                 for (int q = 0; q < 16; ++q) {
                   const int tk = kb * 32 + crow(q, lh);
                   int df = tq - tk; df = df < 0 ? -df : df;
                   s[q] = (df <= 128) ? s[q] * QSCALE : NEGF;
                 }
                 return 1.f;
               });
      attn_store(st, P.y + ((size_t)b * PB + pq) * D + hq * 64, lr, lh);
    } else {
      const int r2 = it - n_lat;
      const int b = r2 >> 5, hq = (r2 >> 1) & 15, half = r2 & 1;
      const int qblk = half * 4 + w, kvh = hq >> 2;
      attn_init(st, sink[hq] * LOG2E, 1.f);
      attn_qload(Q + ((size_t)(b * 16 + hq) * PB + qblk * 32) * 64, lr, lh, qf);
      attn_run(st, qf, Kk + (size_t)(b * 4 + kvh) * PB * 64, Vt + (size_t)(b * 4 + kvh) * 64 * PB, 8, lr, lh,
               [&](int jb) { return jb * 32; },
               [&](int jb, f32x16& s) {
                 return QSCALE;
               });
      attn_store(st, P.y + ((size_t)b * PB + qblk * 32) * D + hq * 64, lr, lh);
    }
  }
}

DI void gla_cumsum(const Params& P, int jl, int b, int h, int c, float* LB, float* ZT) {
  const int tid = tid_l(), dk = tid & 63, tg = tid >> 6;
  const float* wa2 = P.gla_wa2 + (size_t)jl * 2 * 16 * 256;
  const float* ba = P.gla_ba + (size_t)jl * 2 * 256;
  {
    const float4* zsrc = (const float4*)(P.z + ((size_t)b * PB + c * 64) * 32);
    ((float4*)ZT)[tid] = zsrc[tid];
    ((float4*)ZT)[tid + 256] = zsrc[tid + 256];
  }
  __syncthreads();
  float lf[16], lbk[16];
#pragma unroll
  for (int dir = 0; dir < 2; ++dir) {
    float wc[16];
#pragma unroll
    for (int r = 0; r < 16; ++r) wc[r] = wa2[(dir * 16 + r) * 256 + h * 64 + dk];
    const float bias = ba[dir * 256 + h * 64 + dk];
#pragma unroll
    for (int tt = 0; tt < 16; ++tt) {
      const int t = tg * 16 + tt;
      const float4* zr = (const float4*)(ZT + t * 32 + dir * 16);
      float acc = bias;
#pragma unroll
      for (int r4 = 0; r4 < 4; ++r4) {
        const float4 zv = zr[r4];
        acc += zv.x * wc[4 * r4] + zv.y * wc[4 * r4 + 1] + zv.z * wc[4 * r4 + 2] + zv.w * wc[4 * r4 + 3];
      }
      const float ls = (fminf(acc, 0.f) - __logf(1.f + __expf(-fabsf(acc)))) * (1.f / 16.f);
      if (dir == 0) lf[tt] = ls; else lbk[tt] = ls;
    }
  }
#pragma unroll
  for (int tt = 1; tt < 16; ++tt) lf[tt] += lf[tt - 1];
#pragma unroll
  for (int tt = 14; tt >= 0; --tt) lbk[tt] += lbk[tt + 1];
  __syncthreads();
  ZT[tg * 64 + dk] = lf[15];
  ZT[256 + tg * 64 + dk] = lbk[0];
  __syncthreads();
  float of = 0.f, ob = 0.f;
#pragma unroll
  for (int g = 0; g < 4; ++g) {
    if (g < tg) of += ZT[g * 64 + dk];
    if (g > tg) ob += ZT[256 + g * 64 + dk];
  }
#pragma unroll
  for (int tt = 0; tt < 16; ++tt) {
    const int t = tg * 16 + tt;
    LB[t * 64 + dk] = lf[tt] + of;
    LB[(64 + t) * 64 + dk] = lbk[tt] + ob;
  }
  __syncthreads();
}

DI void phase_gla1(const Params& P, int jl, char* smem, int bid, int nb) {
  float* LB = (float*)smem;
  bfu* KD = (bfu*)(smem + 32768);
  const int tid = tid_l(), lane = tid & 63, w = tid >> 6, lr = lane & 31, lh = lane >> 5;
  for (int it = bid; it < 16 * 68; it += nb) {
    const int bh = it / 68, c = it % 68, b = bh >> 2, h = bh & 3;
    __syncthreads();
    gla_cumsum(P, jl, b, h, c, LB, (float*)(smem + 49152));
    const bfu* kp = P.kb + ((size_t)bh * PB + c * 64) * 64;
    {
      const int dk = tid & 63;
      const float endf = LB[63 * 64 + dk], endb = LB[64 * 64 + dk];
#pragma unroll
      for (int it2 = 0; it2 < 2; ++it2) {
        const int t0 = ((tid >> 6) + 4 * it2) * 8;
        float vf[8], vb[8];
#pragma unroll
        for (int j = 0; j < 8; ++j) {
          const float kv = bf2f(kp[(t0 + j) * 64 + dk]);
          vf[j] = kv * __expf(endf - LB[(t0 + j) * 64 + dk]);
          vb[j] = kv * __expf(endb - LB[(64 + t0 + j) * 64 + dk]);
        }
        *(bf16x8*)(KD + swz(dk, t0)) = pack8(vf);
        *(bf16x8*)(KD + 4096 + swz(dk, t0)) = pack8(vb);
      }
    }
    if (tid < 128) {
      const int dir = tid >> 6, dk = tid & 63;
      P.decay[((size_t)(dir * 16 + bh) * 68 + c) * 64 + dk] = __expf(dir == 0 ? LB[63 * 64 + dk] : LB[64 * 64 + dk]);
    }
    __syncthreads();
    const int dir = w >> 1, dvh = w & 1;
    f32x16 acc[2][2];
#pragma unroll
    for (int i = 0; i < 2; ++i)
#pragma unroll
      for (int j = 0; j < 2; ++j)
#pragma unroll
        for (int r = 0; r < 16; ++r) acc[i][j][r] = 0.f;
    const bfu* vp = P.vbT + ((size_t)bh * 128 + dvh * 64 + lr) * PB + c * 64;
#pragma unroll
    for (int ks = 0; ks < 4; ++ks) {
      bf16x8 af[2], bfr[2];
#pragma unroll
      for (int i = 0; i < 2; ++i) af[i] = *(const bf16x8*)(KD + dir * 4096 + swz(i * 32 + lr, ks * 16 + lh * 8));
#pragma unroll
      for (int j = 0; j < 2; ++j) bfr[j] = *(const bf16x8*)(vp + (size_t)(j * 32) * PB + ks * 16 + lh * 8);
#pragma unroll
      for (int i = 0; i < 2; ++i)
#pragma unroll
        for (int j = 0; j < 2; ++j) acc[i][j] = MFMA(af[i], bfr[j], acc[i][j]);
    }
    bfu* ds = P.dstate + ((size_t)(dir * 16 + bh) * 68 + c) * 8192;
#pragma unroll
    for (int i = 0; i < 2; ++i)
#pragma unroll
      for (int j = 0; j < 2; ++j)
#pragma unroll
        for (int g = 0; g < 4; ++g) {
          const int dk = i * 32 + 8 * g + 4 * lh, dv = dvh * 64 + j * 32 + lr;
          *(s16x4*)(ds + dv * 64 + dk) = pack4(acc[i][j][4 * g], acc[i][j][4 * g + 1], acc[i][j][4 * g + 2], acc[i][j][4 * g + 3]);
        }
  }
}

DI void phase_gla2(const Params& P, int bid, int nb) {
  bfu* Sin = P.h;
  for (int idx = bid * 256 + tid_l(); idx < 32 * 2048; idx += nb * 256) {
    const int chain = idx >> 11, e4 = idx & 2047;
    const int dir = chain >> 4;
    const int dk = (e4 * 4) & 63;
    float s0 = 0.f, s1 = 0.f, s2 = 0.f, s3 = 0.f;
#pragma unroll 4
    for (int step = 0; step < 68; ++step) {
      const int c = dir == 0 ? step : (step < 4 ? 3 - step : 71 - step);
      const size_t base = ((size_t)chain * 68 + c) * 8192 + e4 * 4;
      *(s16x4*)(Sin + base) = pack4(s0, s1, s2, s3);
      const s16x4 d = *(const s16x4*)(P.dstate + base);
      const float4 dec = *(const float4*)(P.decay + ((size_t)chain * 68 + c) * 64 + dk);
      s0 = dec.x * s0 + bf2f((bfu)d[0]);
      s1 = dec.y * s1 + bf2f((bfu)d[1]);
      s2 = dec.z * s2 + bf2f((bfu)d[2]);
      s3 = dec.w * s3 + bf2f((bfu)d[3]);
    }
  }
}

DI void phase_gla3(const Params& P, int jl, char* smem, int bid, int nb) {
  float* LB = (float*)smem;
  bfu* QT = (bfu*)(smem + 32768);
  bfu* KT = QT + 8192;
  const bfu* Sin = P.h;
  const int tid = tid_l(), lane = tid & 63, w = tid >> 6, lr = lane & 31, lh = lane >> 5;
  const float* gg = P.gla_g + (size_t)jl * 512;
  for (int it = bid; it < 16 * 68; it += nb) {
    const int bh = it / 68, c = it % 68, b = bh >> 2, h = bh & 3;
    __syncthreads();
    gla_cumsum(P, jl, b, h, c, LB, (float*)KT);
    {
      const bfu* qp = P.qb + ((size_t)bh * PB + c * 64) * 64;
      const bfu* kp = P.kb + ((size_t)bh * PB + c * 64) * 64;
#pragma unroll
      for (int it2 = 0; it2 < 2; ++it2) {
        const int e8 = tid + 256 * it2, t = e8 >> 3, c8 = e8 & 7;
        const bf16x8 q8 = *(const bf16x8*)(qp + t * 64 + c8 * 8);
        const bf16x8 k8 = *(const bf16x8*)(kp + t * 64 + c8 * 8);
        float bfv[8], bbv[8];
        *(float4*)&bfv[0] = *(const float4*)(LB + t * 64 + c8 * 8);
        *(float4*)&bfv[4] = *(const float4*)(LB + t * 64 + c8 * 8 + 4);
        *(float4*)&bbv[0] = *(const float4*)(LB + (64 + t) * 64 + c8 * 8);
        *(float4*)&bbv[4] = *(const float4*)(LB + (64 + t) * 64 + c8 * 8 + 4);
        float qf_[8], kf_[8], qb_[8], kb_[8];
#pragma unroll
        for (int j = 0; j < 8; ++j) {
          const float qv = bf2f((bfu)q8[j]), kv = bf2f((bfu)k8[j]);
          qf_[j] = qv * __expf(bfv[j]); kf_[j] = kv * __expf(-bfv[j]);
          qb_[j] = qv * __expf(bbv[j]); kb_[j] = kv * __expf(-bbv[j]);
        }
        const int a = swz(t, c8 * 8);
        *(bf16x8*)(QT + a) = pack8(qf_); *(bf16x8*)(KT + a) = pack8(kf_);
        *(bf16x8*)(QT + 4096 + a) = pack8(qb_); *(bf16x8*)(KT + 4096 + a) = pack8(kb_);
      }
    }
    __syncthreads();
    {
      const int dir = w >> 1, qh = w & 1;
      f32x16 att[2];
#pragma unroll
      for (int j = 0; j < 2; ++j)
#pragma unroll
        for (int r = 0; r < 16; ++r) att[j][r] = 0.f;
#pragma unroll
      for (int ks = 0; ks < 4; ++ks) {
        const bf16x8 a = *(const bf16x8*)(QT + dir * 4096 + swz(qh * 32 + lr, ks * 16 + lh * 8));
#pragma unroll
        for (int j = 0; j < 2; ++j) {
          const bf16x8 bb = *(const bf16x8*)(KT + dir * 4096 + swz(j * 32 + lr, ks * 16 + lh * 8));
          att[j] = MFMA(a, bb, att[j]);
        }
      }
      __syncthreads();
#pragma unroll
      for (int j = 0; j < 2; ++j)
#pragma unroll
        for (int r = 0; r < 16; ++r) {
          const int tq = qh * 32 + crow(r, lh), tk = j * 32 + lr;
          const bool keep = dir == 0 ? (tk <= tq) : (tk >= tq);
          KT[dir * 4096 + swz(tq, tk)] = f2bf(keep ? att[j][r] : 0.f);
        }
    }
    __syncthreads();
    {
      const int qh = w & 1, dvh = w >> 1;
      f32x16 o[2];
#pragma unroll
      for (int j = 0; j < 2; ++j)
#pragma unroll
        for (int r = 0; r < 16; ++r) o[j][r] = 0.f;
#pragma unroll
      for (int dir = 0; dir < 2; ++dir) {
        const bfu* vp = P.vbT + ((size_t)bh * 128 + dvh * 64 + lr) * PB + c * 64;
        const bfu* sp = Sin + ((size_t)(dir * 16 + bh) * 68 + c) * 8192 + (size_t)(dvh * 64 + lr) * 64;
#pragma unroll
        for (int ks = 0; ks < 4; ++ks) {
          const bf16x8 a1 = *(const bf16x8*)(KT + dir * 4096 + swz(qh * 32 + lr, ks * 16 + lh * 8));
          const bf16x8 a2 = *(const bf16x8*)(QT + dir * 4096 + swz(qh * 32 + lr, ks * 16 + lh * 8));
#pragma unroll
          for (int j = 0; j < 2; ++j) {
            const bf16x8 b1 = *(const bf16x8*)(vp + (size_t)(j * 32) * PB + ks * 16 + lh * 8);
            const bf16x8 b2 = *(const bf16x8*)(sp + (size_t)(j * 32) * 64 + ks * 16 + lh * 8);
            o[j] = MFMA(a1, b1, o[j]);
            o[j] = MFMA(a2, b2, o[j]);
          }
        }
      }
#pragma unroll
      for (int j = 0; j < 2; ++j)
#pragma unroll
        for (int r = 0; r < 16; ++r) LB[(qh * 32 + crow(r, lh)) * 128 + dvh * 64 + j * 32 + lr] = o[j][r];
    }
    __syncthreads();
    {
      const int t = tid >> 2, seg = tid & 3;
      float4 ov[8];
      float ss = 0.f;
#pragma unroll
      for (int k = 0; k < 8; ++k) {
        const int kk = (k + t) & 7;
        ov[k] = *(const float4*)(LB + t * 128 + seg * 32 + kk * 4);
        ss += ov[k].x * ov[k].x + ov[k].y * ov[k].y + ov[k].z * ov[k].z + ov[k].w * ov[k].w;
      }
      ss += __shfl_xor(ss, 1);
      ss += __shfl_xor(ss, 2);
      const float rs = rsqrtf(ss * (1.f / 128.f) + EPSF);
      const size_t m = (size_t)b * PB + c * 64 + t;
#pragma unroll
      for (int k = 0; k < 8; ++k) {
        const int kk = (k + t) & 7;
        const int col = h * 128 + seg * 32 + kk * 4;
        const s16x4 rv = *(const s16x4*)(P.rb + m * 512 + col);
        const float4 g4 = *(const float4*)(gg + col);
        *(s16x4*)(P.y + m * D + 512 + col) = pack4(ov[k].x * rs * g4.x * siluf(bf2f((bfu)rv[0])), ov[k].y * rs * g4.y * siluf(bf2f((bfu)rv[1])),
                                                   ov[k].z * rs * g4.z * siluf(bf2f((bfu)rv[2])), ov[k].w * rs * g4.w * siluf(bf2f((bfu)rv[3])));
      }
    }
  }
}

__global__ void __launch_bounds__(256, 2) mega(Params P) {
  cg::grid_group grid = cg::this_grid();
  __shared__ __attribute__((aligned(16))) char smem[65536];
  const int bid = blockIdx.x, nb = gridDim.x;
  XcdBarrier xb = xcd_barrier_post(P.bar);
#define GSYNC() xcd_barrier(xb)

  for (int rep = 0; rep < REP_CONV; ++rep) { phase_convert_layer(P, 0, smem, bid, nb);
  phase_modp(P, smem, bid, nb);
  phase_rope(P, bid, nb); }
  if (P.out == nullptr) grid.sync();
  GSYNC();
  phase_modreduce(P, bid, nb);
  GSYNC();
  phase_rows0(P, 0, 0, nullptr, nullptr, P.g_mix_pre, P.mod + 0 * 1024, P.mod + 1 * 1024, bid, nb);
  GSYNC();

#pragma unroll 1
  for (int l = 0; l < 4; ++l) {
    const int jl = l >> 1;
    const int last = (l == 3);
    const float* modl = P.mod + (size_t)l * 5 * 6144;
    if ((l & 1) == 0) {
      for (int rep = 0; rep < REP_GEMM; ++rep) phase_gemm_inab(P, smem, bid, nb);
      GSYNC();
      for (int rep = 0; rep < REP_MIX; ++rep) { phase_na(P, jl, smem, bid, nb);
      phase_gla1(P, jl, smem, bid, nb); }
      GSYNC();
      for (int rep = 0; rep < REP_MIX; ++rep) phase_gla2(P, bid, nb);
      GSYNC();
      for (int rep = 0; rep < REP_MIX; ++rep) phase_gla3(P, jl, smem, bid, nb);
      GSYNC();
    } else {
      for (int rep = 0; rep < REP_GEMM; ++rep) phase_gemm_inc(P, smem, bid, nb);
      GSYNC();
      for (int rep = 0; rep < REP_MIX; ++rep) phase_swa(P, jl, !last, bid, nb);
      GSYNC();
    }
    for (int rep = 0; rep < REP_GEMM; ++rep) phase_gemm_f32(P, P.y, P.wout_t, D, D, (bfu*)P.yo, last, smem, bid, nb);
    GSYNC();
    phase_rows(P, 1, last, P.g_mix_post + l * D, modl + 2 * 1024, P.g_ffn_pre + l * D, modl + 3 * 1024, modl + 4 * 1024, bid, nb);
    GSYNC();
    for (int rep = 0; rep < REP_GEMM; ++rep) phase_gemm_wup(P, l, last, smem, bid, nb);
    GSYNC();
    phase_fix(P, l, last, bid, nb);
    GSYNC();
    for (int rep = 0; rep < REP_GEMM; ++rep) phase_gemm_f32(P, P.a, P.wdown_t, DFF, D, (bfu*)P.yo, last, smem, bid, nb);
    GSYNC();
    if (!last) {
      const float* modn = P.mod + (size_t)(l + 1) * 5 * 6144;
      phase_rows(P, 1, 0, P.g_ffn_post + l * D, modl + 5 * 1024, P.g_mix_pre + (l + 1) * D, modn + 0 * 1024, modn + 1 * 1024, bid, nb);
      for (int rep = 0; rep < REP_CONV; ++rep) phase_convert_layer(P, l + 1, smem, bid, nb);
      GSYNC();
    } else {
      phase_rows(P, 2, 1, P.g_ffn_post + l * D, modl + 5 * 1024, nullptr, nullptr, nullptr, bid, nb);
    }
  }
}

extern "C" void kernel_launch(void* const* d_in, const int* in_sizes, int n_in, void* d_out,
                              int out_size, void* d_ws, size_t ws_size, hipStream_t stream) {
  static int grid_blocks = 0;
  if (!grid_blocks) {
    int dev = 0, cus = 0, per_cu = 0;
    (void)hipGetDevice(&dev);
    (void)hipDeviceGetAttribute(&cus, hipDeviceAttributeMultiprocessorCount, dev);
    (void)hipOccupancyMaxActiveBlocksPerMultiprocessor(&per_cu, mega, 256, 0);
    if (per_cu > 2) per_cu = 2;
    if (per_cu < 1) per_cu = 1;
    grid_blocks = cus * per_cu;
  }
  Params p{};
  const float* const* in = (const float* const*)d_in;
  p.x = in[0]; p.c = in[1]; p.ctx = in[2]; p.c_ctx = in[3]; p.w_mod = in[4]; p.b_mod = in[5];
  p.g_mix_pre = in[6]; p.g_mix_post = in[7]; p.g_ffn_pre = in[8]; p.g_ffn_post = in[9];
  p.w_out = in[10]; p.w_up = in[11]; p.conv_w = in[12]; p.conv_b = in[13]; p.w_down = in[14];
  p.w_in_ab = in[15]; p.na_rpb = in[16]; p.gla_wa2 = in[17]; p.gla_ba = in[18]; p.gla_g = in[19];
  p.w_in_c = in[20]; p.swa_sink = in[21];
  p.out = (float*)d_out;
  char* base = (char*)d_ws;
  size_t off = 0;
  auto take = [&](size_t bytes) { char* r = base + off; off += (bytes + 255) & ~(size_t)255; return r; };
  const size_t M = MTOT;
  p.bar = (unsigned*)take((size_t)XCD_BAR_WORDS * 4);
  p.wout_t = (bfu*)take((size_t)1024 * 1024 * 2);
  p.wup_t = (bfu*)take((size_t)5632 * 1024 * 2);
  p.wdown_t = (bfu*)take((size_t)1024 * 2816 * 2);
  p.win_t = (bfu*)take((size_t)3200 * 1024 * 2);
  p.modp = (float*)take((size_t)4 * 32 * 5 * 6144 * 4);
  p.mod = (float*)take((size_t)4 * 5 * 6144 * 4);
  p.rope = (float2*)take((size_t)4096 * 32 * 8);
  p.xres = (float*)take(M * 1024 * 4);
  p.h = (bfu*)take(M * 1024 * 2);
  char* ra = take(0);
  p.yo = (float*)ra;
  p.qa = (bfu*)ra;
  p.ka = p.qa + M * 512;
  p.vaT = p.ka + M * 512;
  p.qb = p.vaT + M * 512;
  p.kb = p.qb + M * 256;
  char* rb2 = ra + M * 4096;
  p.a = (bfu*)rb2;
  p.y = (bfu*)rb2;
  p.vbT = p.y + M * 1024;
  p.rb = p.vbT + M * 512;
  p.z = (float*)(p.rb + M * 512);
  p.decay = p.z + M * 32;
  char* rc = rb2 + M * 2816 * 2;
  p.ub = (float*)rc;
  p.dstate = (bfu*)rc;
  off += M * 4096 + M * 2816 * 2 + (size_t)2 * 16 * 68 * 8192 * 2 + 4096;
  if (off > ws_size) {
    fprintf(stderr, "workspace too small: need %zu have %zu\n", off, ws_size);
    return;
  }
  (void)hipMemsetAsync(p.bar, 0, (size_t)XCD_BAR_WORDS * 4, stream);
  void* args[] = {&p};
  hipError_t e = hipLaunchCooperativeKernel((void*)mega, dim3(grid_blocks), dim3(256), args, 0, stream);
  if (e != hipSuccess) fprintf(stderr, "cooperative launch failed: %s (grid %d)\n", hipGetErrorString(e), grid_blocks);
}
```

```cpp
#include <hip/hip_runtime.h>
#include <hip/hip_cooperative_groups.h>
#include <cstdio>
namespace cg = cooperative_groups;

#define DI __device__ __forceinline__
typedef unsigned short bfu;
typedef __attribute__((ext_vector_type(8))) short bf16x8;
typedef __attribute__((ext_vector_type(4))) short s16x4;
typedef __attribute__((ext_vector_type(16))) float f32x16;
typedef __attribute__((ext_vector_type(4))) unsigned u32x4;
#define MFMA(a, b, c) __builtin_amdgcn_mfma_f32_32x32x16_bf16((a), (b), (c), 0, 0, 0)

constexpr int D = 1024;
constexpr int PB = 4352;
constexpr int MTOT = 4 * PB;
constexpr int DFF = 2816;
constexpr float EPSF = 1e-6f;
constexpr float NEGF = -1e30f;
constexpr float LOG2E = 1.4426950408889634f;
constexpr float QSCALE = 0.125f * 1.4426950408889634f;
#ifndef REP_GEMM
#define REP_GEMM 1
#endif
#ifndef REP_MIX
#define REP_MIX 1
#endif
#ifndef REP_SYNC
#define REP_SYNC 1
#endif
#ifndef REP_CONV
#define REP_CONV 1
#endif
#ifndef REP_ROWS
#define REP_ROWS 1
#endif

struct Params {
  const float *x, *c, *ctx, *c_ctx, *w_mod, *b_mod, *g_mix_pre, *g_mix_post, *g_ffn_pre, *g_ffn_post;
  const float *w_out, *w_up, *conv_w, *conv_b, *w_down, *w_in_ab, *na_rpb, *gla_wa2, *gla_ba, *gla_g, *w_in_c, *swa_sink;
  float* out;
  bfu *wout_t, *wup_t, *wdown_t, *win_t;
  float *modp, *mod;
  float2* rope;
  float* xres;
  bfu* h;
  float* yo;
  bfu *qa, *ka, *vaT, *qb, *kb;
  bfu *y, *vbT, *rb;
  float *z, *decay;
  bfu* a;
  float* ub;
  bfu* dstate;
  unsigned* bar;
};

DI int tid_l() { int t = threadIdx.x; asm volatile("" : "+v"(t)); return t; }
typedef __bf16 bf2_t __attribute__((ext_vector_type(2)));
typedef float f2_t __attribute__((ext_vector_type(2)));
typedef __attribute__((ext_vector_type(2))) unsigned u32x2;
DI unsigned pk_bf16(float a, float b) { f2_t v = {a, b}; return __builtin_bit_cast(unsigned, __builtin_convertvector(v, bf2_t)); }
DI bfu f2bf(float x) { return (bfu)(pk_bf16(x, 0.f) & 0xffffu); }
DI float bf2f(bfu v) { return __uint_as_float(((unsigned)v) << 16); }
DI int crow(int r, int h) { return (r & 3) + 8 * (r >> 2) + 4 * h; }
DI float wave_sum(float v) {
#pragma unroll
  for (int o = 32; o >= 1; o >>= 1) v += __shfl_xor(v, o);
  return v;
}
DI float siluf(float v) { return v * __builtin_amdgcn_rcpf(1.f + __builtin_amdgcn_exp2f(-1.4426950408889634f * v)); }
DI s16x4 pack4(float a, float b, float c, float d) {
  u32x2 r; r[0] = pk_bf16(a, b); r[1] = pk_bf16(c, d);
  return __builtin_bit_cast(s16x4, r);
}
DI bf16x8 pack8(const float* p) {
  u32x4 r; r[0] = pk_bf16(p[0], p[1]); r[1] = pk_bf16(p[2], p[3]); r[2] = pk_bf16(p[4], p[5]); r[3] = pk_bf16(p[6], p[7]);
  return __builtin_bit_cast(bf16x8, r);
}
DI int kq_off(int p, int d) { return (p >> 5) * 2048 + ((((d >> 4) * 2 + ((d >> 3) & 1)) * 32 + (p & 31)) << 3) + (d & 7); }
DI int v_off(int p, int d) {
  const int pi = p & 31;
  return (p >> 5) * 2048 + ((((((pi >> 4) * 2 + (d >> 5)) * 2 + ((pi >> 2) & 1)) * 32 + (d & 31)) << 3) + ((pi >> 3) & 1) * 4 + (pi & 3));
}
DI int swz(int row, int col) { return row * 64 + ((((col >> 3) ^ (row & 7))) << 3) + (col & 7); }


#define XB_TMO      128
#define XB_XCNT(j)  (256  + 64 * (j))
#define XB_XSUB(j)  (1280 + 64 * (j))
#define XB_XGEN(j)  (2304 + 64 * (j))
#define XB_TOP      3328
#define XB_TOPGEN   3392
#define XCD_BAR_WORDS 3456
#define XB_SPIN_CAP (1u << 22)
#define LAS __attribute__((address_space(3)))
DI unsigned xb_ld(unsigned* p)              { return __hip_atomic_load(p, __ATOMIC_RELAXED, __HIP_MEMORY_SCOPE_AGENT); }
DI unsigned xb_add(unsigned* p, unsigned v) { return __hip_atomic_fetch_add(p, v, __ATOMIC_RELAXED, __HIP_MEMORY_SCOPE_AGENT); }
DI unsigned xb_xcc_id() { return (unsigned)__builtin_amdgcn_s_getreg((3 << 11) | 20) & 0xFu; }
#define XB_SPIN(cond, bar) do { unsigned _sp = 0; while (cond) { __builtin_amdgcn_s_sleep(6); \
    if ((++_sp & 255u) == 0u) { if (xb_ld(&(bar)[XB_TMO])) break; if (_sp > XB_SPIN_CAP) { atomicAdd(&(bar)[XB_TMO], 1u); break; } } } } while (0)
struct XcdBarrier { unsigned* bar; unsigned x; unsigned nloc, nx; };
DI XcdBarrier xcd_barrier_post(unsigned* bar) {
  XcdBarrier b; b.bar = bar; b.x = xb_xcc_id(); b.nloc = 0u; b.nx = 0u;
  if (threadIdx.x == 0) (void)xb_add(&bar[XB_XCNT(b.x)], 1u);
  return b;
}
DI void xcd_barrier_complete(unsigned* bar, unsigned x, unsigned& nloc, unsigned& nx) {
  const unsigned G = gridDim.x * gridDim.y * gridDim.z;
  unsigned sum, cnt, mine, sp = 0u;
  for (;;) {
    sum = 0u; cnt = 0u; mine = 0u;
#pragma unroll
    for (unsigned j = 0; j < 16; ++j) { const unsigned c = xb_ld(&bar[XB_XCNT(j)]); sum += c; cnt += (c > 0u) ? 1u : 0u; mine = (j == x) ? c : mine; }
    if (sum == G) break;
    __builtin_amdgcn_s_sleep(1);
    if ((++sp & 255u) == 0u) { if (xb_ld(&bar[XB_TMO])) break; if (sp > XB_SPIN_CAP) { atomicAdd(&bar[XB_TMO], 1u); break; } }
  }
  nloc = mine > 0u ? mine : 1u; nx = cnt > 0u ? cnt : 1u;
}
DI void xcd_barrier(XcdBarrier& b) {
  asm volatile("s_waitcnt vmcnt(0)" ::: "memory");
  __syncthreads();
  if (threadIdx.x == 0) {
    unsigned* bar = b.bar;
    __builtin_amdgcn_s_waitcnt(0);
    unsigned nloc = b.nloc, nx = b.nx;
    if (nloc == 0u) { xcd_barrier_complete(bar, b.x, nloc, nx); b.nloc = nloc; b.nx = nx; }
    const unsigned old = xb_add(&bar[XB_XSUB(b.x)], 1u);
    const unsigned gen = old / nloc;
    if (old + 1u == (gen + 1u) * nloc) {
      __builtin_amdgcn_fence(__ATOMIC_RELEASE, "agent");
      asm volatile("s_waitcnt vmcnt(0)" ::: "memory");
      const unsigned og = xb_add(&bar[XB_TOP], 1u);
      const unsigned tg = og / nx;
      if (og + 1u == (tg + 1u) * nx) xb_add(&bar[XB_TOPGEN], 1u);
      else XB_SPIN(xb_ld(&bar[XB_TOPGEN]) == tg, bar);
      __builtin_amdgcn_fence(__ATOMIC_ACQUIRE, "agent");
      xb_add(&bar[XB_XGEN(b.x)], 1u);
      asm volatile("s_waitcnt vmcnt(0)" ::: "memory");
    } else {
      XB_SPIN(xb_ld(&bar[XB_XGEN(b.x)]) == gen, bar);
      __builtin_amdgcn_fence(__ATOMIC_ACQUIRE, "agent");
      asm volatile("s_waitcnt vmcnt(0)" ::: "memory");
    }
  }
  __syncthreads();
}

DI void conv_tile(const float* __restrict__ W, int K, int N, bfu* __restrict__ Wt, int kt, int nt, int perm, float* T) {
  const int tid = tid_l();
  const int k0 = kt * 64, n0 = nt * 64;
  __syncthreads();
  {
    const int n4 = (tid & 15) * 4, kk = tid >> 4;
#pragma unroll
    for (int i = 0; i < 4; ++i) {
      const int k = kk + 16 * i;
      float4 v = make_float4(0.f, 0.f, 0.f, 0.f);
      if (n0 + n4 < N) v = *(const float4*)(W + (size_t)(k0 + k) * N + n0 + n4);
      *(float4*)(T + k * 68 + (n4 ^ (((k >> 3) & 7) << 2))) = v;
    }
  }
  __syncthreads();
  {
    const int k8 = (tid & 7) * 8;
    const int sw = ((k8 >> 3) & 7) << 2;
#pragma unroll
    for (int i = 0; i < 2; ++i) {
      const int n = (tid >> 3) + 32 * i;
      const int ng = n0 + n;
      if (ng < N) {
        float tv[8];
#pragma unroll
        for (int j = 0; j < 8; ++j) tv[j] = T[(k8 + j) * 68 + (n ^ sw)];
        const bf16x8 v = pack8(tv);
        int nd = ng;
        if (perm) {
          if (ng < DFF) nd = (ng >> 6) * 128 + ((ng >> 5) & 1) * 64 + (ng & 31);
          else { const int n2 = ng - DFF; nd = (n2 >> 6) * 128 + ((n2 >> 5) & 1) * 64 + 32 + (n2 & 31); }
        }
        *(bf16x8*)(Wt + (size_t)nd * K + k0 + k8) = v;
      }
    }
  }
}

DI void phase_convert_layer(const Params& P, int l, char* smem, int bid, int nb) {
  float* T = (float*)smem;
  const int j = l >> 1;
  const int n_in = (l & 1) ? 1536 : 3104;
  const int nt_in = (n_in + 63) / 64;
  const float* w_in = (l & 1) ? (P.w_in_c + (size_t)j * D * 1536) : (P.w_in_ab + (size_t)j * D * 3104);
  const int c0 = 256, c1 = c0 + 16 * 88, c2 = c1 + 44 * 16, c3 = c2 + 16 * nt_in;
  for (int it = bid; it < c3; it += nb) {
    if (it < c0) conv_tile(P.w_out + (size_t)l * D * D, D, D, P.wout_t, it / 16, it % 16, 0, T);
    else if (it < c1) { const int r = it - c0; conv_tile(P.w_up + (size_t)l * D * 2 * DFF, D, 2 * DFF, P.wup_t, r / 88, r % 88, 1, T); }
    else if (it < c2) { const int r = it - c1; conv_tile(P.w_down + (size_t)l * DFF * D, DFF, D, P.wdown_t, r / 16, r % 16, 0, T); }
    else { const int r = it - c2; conv_tile(w_in, D, n_in, P.win_t, r / nt_in, r % nt_in, 0, T); }
  }
}

DI void phase_modp(const Params& P, char* smem, int bid, int nb) {
  float* sv = (float*)smem;
  const int tid = tid_l();
  for (int it = bid; it < 4 * 32 * 6; it += nb) {
    const int l = it / 192, r = it % 192, ks = r / 6, nblk = r % 6;
    __syncthreads();
    if (tid < 160) {
      const int s = tid >> 5, k = ks * 32 + (tid & 31);
      const float cv = (s < 4) ? P.c[s * D + k] : P.c_ctx[k];
      sv[tid] = cv / (1.f + expf(-cv));
    }
    __syncthreads();
    const int n = nblk * 1024 + tid * 4;
    float4 acc[5];
#pragma unroll
    for (int s = 0; s < 5; ++s) acc[s] = make_float4(0.f, 0.f, 0.f, 0.f);
    const float* wp = P.w_mod + ((size_t)l * D + ks * 32) * 6144 + n;
#pragma unroll 8
    for (int k = 0; k < 32; ++k) {
      const float4 w = *(const float4*)(wp + (size_t)k * 6144);
#pragma unroll
      for (int s = 0; s < 5; ++s) {
        const float sc = sv[s * 32 + k];
        acc[s].x += sc * w.x; acc[s].y += sc * w.y; acc[s].z += sc * w.z; acc[s].w += sc * w.w;
      }
    }
#pragma unroll
    for (int s = 0; s < 5; ++s) *(float4*)(P.modp + ((size_t)(l * 32 + ks) * 5 + s) * 6144 + n) = acc[s];
  }
}

DI void phase_rope(const Params& P, int bid, int nb) {
  for (int idx = bid * 256 + tid_l(); idx < 4096 * 32; idx += nb * 256) {
    const int t = idx >> 5, i = idx & 31;
    const int row = t >> 6, col = t & 63;
    const int j = i & 15;
    const float inv = 1.0f / powf(10000.0f, (float)(2 * j) / 32.0f);
    const float ang = (float)((i < 16) ? row : col) * inv;
    P.rope[idx] = make_float2(cosf(ang), sinf(ang));
  }
}

DI void phase_modreduce(const Params& P, int bid, int nb) {
  for (int idx = bid * 256 + tid_l(); idx < 4 * 5 * 6144; idx += nb * 256) {
    const int l = idx / (5 * 6144), r = idx % (5 * 6144), s = r / 6144, n = r % 6144;
    float acc = P.b_mod[l * 6144 + n];
#pragma unroll
    for (int ks = 0; ks < 32; ++ks) acc += P.modp[((size_t)(l * 32 + ks) * 5 + s) * 6144 + n];
    P.mod[idx] = acc;
  }
}

DI void phase_rows0(const Params& P, int mode, int lat_only, const float* gpost, const float* modl_gate  ,
                   const float* gpre, const float* modl_shift, const float* modl_scale, int bid, int nb) {
  const int lane = tid_l() & 63;
  const int wid = bid * 4 + (tid_l() >> 6), nw = nb * 4;
  for (int m = wid; m < MTOT; m += nw) {
    const int b = m / PB, p = m % PB;
    if (lat_only && p < 256) continue;
    const int s = (p < 256) ? 4 : b;
    float4 v[4];
    if (mode == 0) {
      const float* src = (p < 256) ? (P.ctx + ((size_t)b * 256 + p) * D) : (P.x + ((size_t)b * 4096 + (p - 256)) * D);
#pragma unroll
      for (int i = 0; i < 4; ++i) v[i] = *(const float4*)(src + lane * 4 + 256 * i);
    } else {
      const float* xr = P.xres + (size_t)m * D;
      const float* yr = P.yo + (size_t)m * D;
      float4 yv[4];
      float ss = 0.f;
#pragma unroll
      for (int i = 0; i < 4; ++i) {
        v[i] = *(const float4*)(xr + lane * 4 + 256 * i);
        yv[i] = *(const float4*)(yr + lane * 4 + 256 * i);
        ss += yv[i].x * yv[i].x + yv[i].y * yv[i].y + yv[i].z * yv[i].z + yv[i].w * yv[i].w;
      }
      ss = wave_sum(ss);
      const float rs = rsqrtf(ss * (1.f / 1024.f) + EPSF);
      const float* gate = modl_gate + (size_t)s * 6144;
#pragma unroll
      for (int i = 0; i < 4; ++i) {
        const int e = lane * 4 + 256 * i;
        const float4 gp = *(const float4*)(gpost + e);
        const float4 gt = *(const float4*)(gate + e);
        v[i].x += gt.x * (yv[i].x * rs * gp.x);
        v[i].y += gt.y * (yv[i].y * rs * gp.y);
        v[i].z += gt.z * (yv[i].z * rs * gp.z);
        v[i].w += gt.w * (yv[i].w * rs * gp.w);
      }
    }
    if (mode == 2) {
      float* o = P.out + ((size_t)b * 4096 + (p - 256)) * D;
#pragma unroll
      for (int i = 0; i < 4; ++i) *(float4*)(o + lane * 4 + 256 * i) = v[i];
      continue;
    }
    {
      float* xr = P.xres + (size_t)m * D;
#pragma unroll
      for (int i = 0; i < 4; ++i) *(float4*)(xr + lane * 4 + 256 * i) = v[i];
    }
    float ss2 = 0.f;
#pragma unroll
    for (int i = 0; i < 4; ++i) ss2 += v[i].x * v[i].x + v[i].y * v[i].y + v[i].z * v[i].z + v[i].w * v[i].w;
    ss2 = wave_sum(ss2);
    const float rs2 = rsqrtf(ss2 * (1.f / 1024.f) + EPSF);
    const float* sh = modl_shift + (size_t)s * 6144;
    const float* sc = modl_scale + (size_t)s * 6144;
    bfu* hr = P.h + (size_t)m * D;
#pragma unroll
    for (int i = 0; i < 4; ++i) {
      const int e = lane * 4 + 256 * i;
      const float4 g = *(const float4*)(gpre + e);
      const float4 a = *(const float4*)(sh + e);
      const float4 c = *(const float4*)(sc + e);
      *(s16x4*)(hr + e) = pack4((v[i].x * rs2 * g.x) * (1.f + c.x) + a.x, (v[i].y * rs2 * g.y) * (1.f + c.y) + a.y,
                                (v[i].z * rs2 * g.z) * (1.f + c.z) + a.z, (v[i].w * rs2 * g.w) * (1.f + c.w) + a.w);
    }
  }
}

DI void phase_rows(const Params& P, int mode, int lat_only, const float* gpost, const float* modl_gate,
                   const float* gpre, const float* modl_shift, const float* modl_scale, int bid, int nb) {
  const int lane = tid_l() & 63;
  const int wid = bid * 4 + (tid_l() >> 6), nw = nb * 4;
  const int NR = lat_only ? 16384 : MTOT;
  float4 gp[4], gq[4];
#pragma unroll
  for (int i = 0; i < 4; ++i) {
    gp[i] = *(const float4*)(gpost + lane * 4 + 256 * i);
    gq[i] = (mode == 1) ? *(const float4*)(gpre + lane * 4 + 256 * i) : make_float4(0.f, 0.f, 0.f, 0.f);
  }
  float4 xv[4], yv[4], xn[4], yn[4];
  int ri = wid;
  if (ri < NR) {
    const int m = lat_only ? ((ri >> 12) * PB + 256 + (ri & 4095)) : ri;
#pragma unroll
    for (int i = 0; i < 4; ++i) {
      xv[i] = *(const float4*)(P.xres + (size_t)m * D + lane * 4 + 256 * i);
      const s16x4 yb = *(const s16x4*)((const bfu*)P.yo + (size_t)m * D + lane * 4 + 256 * i);
      yv[i] = make_float4(bf2f((bfu)yb[0]), bf2f((bfu)yb[1]), bf2f((bfu)yb[2]), bf2f((bfu)yb[3]));
    }
  }
  for (; ri < NR; ri += nw) {
    const int m = lat_only ? ((ri >> 12) * PB + 256 + (ri & 4095)) : ri;
    const int b = m / PB, p = m % PB;
    const int s = (p < 256) ? 4 : b;
    const int rn = ri + nw;
    if (rn < NR) {
      const int mn = lat_only ? ((rn >> 12) * PB + 256 + (rn & 4095)) : rn;
#pragma unroll
      for (int i = 0; i < 4; ++i) {
        xn[i] = *(const float4*)(P.xres + (size_t)mn * D + lane * 4 + 256 * i);
        const s16x4 yb = *(const s16x4*)((const bfu*)P.yo + (size_t)mn * D + lane * 4 + 256 * i);
        yn[i] = make_float4(bf2f((bfu)yb[0]), bf2f((bfu)yb[1]), bf2f((bfu)yb[2]), bf2f((bfu)yb[3]));
      }
    }
    const float* gate = modl_gate + (size_t)s * 6144;
    float4 gt[4], sh[4], sc[4];
#pragma unroll
    for (int i = 0; i < 4; ++i) gt[i] = *(const float4*)(gate + lane * 4 + 256 * i);
    if (mode == 1) {
#pragma unroll
      for (int i = 0; i < 4; ++i) {
        sh[i] = *(const float4*)(modl_shift + (size_t)s * 6144 + lane * 4 + 256 * i);
        sc[i] = *(const float4*)(modl_scale + (size_t)s * 6144 + lane * 4 + 256 * i);
      }
    }
    float ss = 0.f;
#pragma unroll
    for (int i = 0; i < 4; ++i) ss += yv[i].x * yv[i].x + yv[i].y * yv[i].y + yv[i].z * yv[i].z + yv[i].w * yv[i].w;
    ss = wave_sum(ss);
    const float rs = rsqrtf(ss * (1.f / 1024.f) + EPSF);
    float4 v[4];
#pragma unroll
    for (int i = 0; i < 4; ++i) {
      v[i].x = xv[i].x + gt[i].x * (yv[i].x * rs * gp[i].x);
      v[i].y = xv[i].y + gt[i].y * (yv[i].y * rs * gp[i].y);
      v[i].z = xv[i].z + gt[i].z * (yv[i].z * rs * gp[i].z);
      v[i].w = xv[i].w + gt[i].w * (yv[i].w * rs * gp[i].w);
    }
    if (mode == 2) {
      float* o = P.out + ((size_t)b * 4096 + (p - 256)) * D;
#pragma unroll
      for (int i = 0; i < 4; ++i) *(float4*)(o + lane * 4 + 256 * i) = v[i];
    } else {
      float* xr = P.xres + (size_t)m * D;
#pragma unroll
      for (int i = 0; i < 4; ++i) *(float4*)(xr + lane * 4 + 256 * i) = v[i];
      float ss2 = 0.f;
#pragma unroll
      for (int i = 0; i < 4; ++i) ss2 += v[i].x * v[i].x + v[i].y * v[i].y + v[i].z * v[i].z + v[i].w * v[i].w;
      ss2 = wave_sum(ss2);
      const float rs2 = rsqrtf(ss2 * (1.f / 1024.f) + EPSF);
      bfu* hr = P.h + (size_t)m * D;
#pragma unroll
      for (int i = 0; i < 4; ++i) {
        const int e = lane * 4 + 256 * i;
        *(s16x4*)(hr + e) = pack4((v[i].x * rs2 * gq[i].x) * (1.f + sc[i].x) + sh[i].x, (v[i].y * rs2 * gq[i].y) * (1.f + sc[i].y) + sh[i].y,
                                  (v[i].z * rs2 * gq[i].z) * (1.f + sc[i].z) + sh[i].z, (v[i].w * rs2 * gq[i].w) * (1.f + sc[i].w) + sh[i].w);
      }
    }
#pragma unroll
    for (int i = 0; i < 4; ++i) { xv[i] = xn[i]; yv[i] = yn[i]; }
  }
}

template <bool TR>
DI void gemm_main(const bfu* __restrict__ A, const bfu* __restrict__ Bt, int K, int m0, int n0, char* smem, f32x16 (&acc)[2][2]) {
  const int tid = tid_l(), lane = tid & 63, w = tid >> 6, wm = w & 1, wn = w >> 1;
  const int lr = lane & 31, lh = lane >> 5;
#pragma unroll
  for (int i = 0; i < 2; ++i)
#pragma unroll
    for (int j = 0; j < 2; ++j)
#pragma unroll
      for (int r = 0; r < 16; ++r) acc[i][j][r] = 0.f;
  const int lrow = tid >> 3, lchunk = tid & 7;
  const bfu* ga = A + (size_t)(m0 + lrow) * K + lchunk * 8;
  const bfu* gb = Bt + (size_t)(n0 + lrow) * K + lchunk * 8;
  const size_t rs32 = (size_t)32 * K;
  char* st_w = smem + lrow * 128 + ((lchunk ^ ((lrow >> 1) & 7)) << 4);
  const int s7 = (lr >> 1) & 7;
  const char* rd_a = smem + (wm * 64 + lr) * 128;
  const char* rd_b = smem + 16384 + (wn * 64 + lr) * 128;
  int off[4];
#pragma unroll
  for (int ks = 0; ks < 4; ++ks) off[ks] = ((ks * 2 + lh) ^ s7) << 4;
  u32x4 ra[4], rb[4];
#define GLOAD1(I, KOFF) { ra[I] = *(const u32x4*)(ga + (I) * rs32 + (KOFF)); rb[I] = *(const u32x4*)(gb + (I) * rs32 + (KOFF)); }
#define LSTORE1(I, STG) { *(u32x4*)(st_w + (STG) * 32768 + (I) * 4096) = ra[I]; *(u32x4*)(st_w + (STG) * 32768 + 16384 + (I) * 4096) = rb[I]; }
#define FREAD(AF, BF, STG, KS)                                      \
  _Pragma("unroll") for (int i = 0; i < 2; ++i) AF[i] = *(const bf16x8*)(rd_a + (STG) * 32768 + i * 4096 + off[KS]);  \
  _Pragma("unroll") for (int j = 0; j < 2; ++j) BF[j] = *(const bf16x8*)(rd_b + (STG) * 32768 + j * 4096 + off[KS]);
#define MMA4(AF, BF)                                                \
  _Pragma("unroll") for (int i = 0; i < 2; ++i)                     \
    _Pragma("unroll") for (int j = 0; j < 2; ++j) acc[i][j] = TR ? MFMA(BF[j], AF[i], acc[i][j]) : MFMA(AF[i], BF[j], acc[i][j]);
#define SB __builtin_amdgcn_sched_barrier(0);
#define GLA_(I, KOFF) { ra[I] = *(const u32x4*)(ga + (I) * rs32 + (KOFF)); }
#define GLB_(I, KOFF) { rb[I] = *(const u32x4*)(gb + (I) * rs32 + (KOFF)); }
#define LSA_(I, STG) { *(u32x4*)(st_w + (STG) * 32768 + (I) * 4096) = ra[I]; }
#define LSB_(I, STG) { *(u32x4*)(st_w + (STG) * 32768 + 16384 + (I) * 4096) = rb[I]; }
#define MMA2(AF, BF, I) __builtin_amdgcn_s_setprio(1); _Pragma("unroll") for (int j = 0; j < 2; ++j) acc[I][j] = TR ? MFMA(BF[j], AF[I], acc[I][j]) : MFMA(AF[I], BF[j], acc[I][j]); __builtin_amdgcn_s_setprio(0);
#define PIECE(P_, RS, DOST, DOLD, KOFF, AF, BF)                     \
    if (DOST) LSA_(P_, 1 - (RS)) if (DOLD) GLA_(P_, KOFF)           \
    SB                                                              \
    MMA2(AF, BF, 0)                                                 \
    SB                                                              \
    if (DOST) LSB_(P_, 1 - (RS)) if (DOLD) GLB_(P_, KOFF)           \
    SB                                                              \
    MMA2(AF, BF, 1)                                                 \
    SB
#define STEP(RS, DOST, DOLD, KOFF) {                                \
    bf16x8 fa0[2], fb0[2], fa1[2], fb1[2];                          \
    FREAD(fa0, fb0, RS, 0)                                          \
    FREAD(fa1, fb1, RS, 1)                                          \
    SB                                                              \
    PIECE(0, RS, DOST, DOLD, KOFF, fa0, fb0)                        \
    FREAD(fa0, fb0, RS, 2)                                          \
    PIECE(1, RS, DOST, DOLD, KOFF, fa1, fb1)                        \
    FREAD(fa1, fb1, RS, 3)                                          \
    PIECE(2, RS, DOST, DOLD, KOFF, fa0, fb0)                        \
    PIECE(3, RS, DOST, DOLD, KOFF, fa1, fb1)                        \
  }
#pragma unroll
  for (int i = 0; i < 4; ++i) GLOAD1(i, 0)
  __syncthreads();
#pragma unroll
  for (int i = 0; i < 4; ++i) LSTORE1(i, 0)
#pragma unroll
  for (int i = 0; i < 4; ++i) GLOAD1(i, 64)
  __syncthreads();
  for (int k0 = 0; k0 < K; k0 += 128) {
    const bool more1 = k0 + 128 < K, more2 = k0 + 192 < K;
    STEP(0, true, more1, k0 + 128)
    __syncthreads();
    STEP(1, more1, more2, k0 + 192)
    __syncthreads();
  }
#undef GLOAD1
#undef LSTORE1
#undef FREAD
#undef MMA4
#undef STEP
#undef SB
}

DI u32x4 merge_groups(u32x2 a, u32x2 b) {
  const u32x2 r0 = __builtin_amdgcn_permlane32_swap(a[0], b[0], false, false);
  const u32x2 r1 = __builtin_amdgcn_permlane32_swap(a[1], b[1], false, false);
  u32x4 o; o[0] = r0[0]; o[1] = r1[0]; o[2] = r0[1]; o[3] = r1[1];
  return o;
}
DI u32x2 pack4u(float a, float b, float c, float d) { u32x2 r; r[0] = pk_bf16(a, b); r[1] = pk_bf16(c, d); return r; }

DI int map_mtile(int idx, int lat_only) {
  if (!lat_only) return idx;
  return (idx >> 5) * 34 + 2 + (idx & 31);
}

DI bool gemm_tile_map(int it, int bid, int nb, int MT, int NT, int& mi, int& ni) {
  const int T = MT * NT, full = T / nb;
  int L;
  if (it < full && (nb & 7) == 0) { const int nloc = nb >> 3; L = (it * 8 + (bid & 7)) * nloc + (bid >> 3); }
  else L = it * nb + bid;
  if (L >= T) return false;
  const int sr = L / (8 * NT), rem = L % (8 * NT);
  ni = rem >> 3;
  mi = sr * 8 + (rem & 7);
  return true;
}

DI void phase_gemm_f32(const Params& P, const bfu* A, const bfu* Bt, int K, int N, bfu* C, int lat_only, char* smem, int bid, int nb) {
  const int NT = N / 128, MT = lat_only ? 128 : 136;
  const int lane = tid_l() & 63, w = tid_l() >> 6, wm = w & 1, wn = w >> 1, lr = lane & 31, lh = lane >> 5;
  for (int it = 0;; ++it) {
    int mi_, ni_;
    if (!gemm_tile_map(it, bid, nb, MT, NT, mi_, ni_)) break;
    const int m0 = map_mtile(mi_, lat_only) * 128, n0 = ni_ * 128;
    f32x16 acc[2][2];
    gemm_main<true>(A, Bt, K, m0, n0, smem, acc);
#pragma unroll
    for (int i = 0; i < 2; ++i) {
      const int m = m0 + wm * 64 + i * 32 + lr;
#pragma unroll
      for (int j = 0; j < 2; ++j)
#pragma unroll
        for (int gp = 0; gp < 4; gp += 2) {
          const u32x4 v = merge_groups(pack4u(acc[i][j][4 * gp], acc[i][j][4 * gp + 1], acc[i][j][4 * gp + 2], acc[i][j][4 * gp + 3]),
                                       pack4u(acc[i][j][4 * gp + 4], acc[i][j][4 * gp + 5], acc[i][j][4 * gp + 6], acc[i][j][4 * gp + 7]));
          *(u32x4*)(C + (size_t)m * N + n0 + wn * 64 + j * 32 + 8 * (gp + lh)) = v;
        }
    }
  }
}

DI void phase_gemm_inab(const Params& P, char* smem, int bid, int nb) {
  const int NT = 25, MT = 136;
  const int lane = tid_l() & 63, w = tid_l() >> 6, wm = w & 1, wn = w >> 1, lr = lane & 31, lh = lane >> 5;
  for (int it = 0;; ++it) {
    int mi_, ni_;
    if (!gemm_tile_map(it, bid, nb, MT, NT, mi_, ni_)) break;
    const int m0 = mi_ * 128, n0 = ni_ * 128;
    f32x16 acc[2][2];
    const bool vtile = (ni_ >= 8 && ni_ < 12) || (ni_ >= 16 && ni_ < 20);
    if (vtile) {
      gemm_main<false>(P.h, P.win_t, D, m0, n0, smem, acc);
#pragma unroll
      for (int i = 0; i < 2; ++i)
#pragma unroll
        for (int j = 0; j < 2; ++j) {
          const int nbase = n0 + wn * 64 + j * 32;
          const int n = nbase + lr;
#pragma unroll
          for (int g = 0; g < 4; ++g) {
            const int m = m0 + wm * 64 + i * 32 + g * 8 + lh * 4;
            const int b = m / PB, p = m % PB;
            const float v0 = acc[i][j][g * 4 + 0], v1 = acc[i][j][g * 4 + 1], v2 = acc[i][j][g * 4 + 2], v3 = acc[i][j][g * 4 + 3];
            if (nbase < 1536) {
              const int nn = n - 1024, head = nn >> 6, d = nn & 63;
              *(s16x4*)(P.vaT + (size_t)(b * 8 + head) * PB * 64 + v_off(p, d)) = pack4(v0, v1, v2, v3);
            } else {
              const int nn = n - 2048, head = nn >> 7, dv = nn & 127;
              *(s16x4*)(P.vbT + ((size_t)(b * 4 + head) * 128 + dv) * PB + p) = pack4(v0, v1, v2, v3);
            }
          }
        }
    } else {
      gemm_main<true>(P.h, P.win_t, D, m0, n0, smem, acc);
#pragma unroll
      for (int i = 0; i < 2; ++i) {
        const int m = m0 + wm * 64 + i * 32 + lr;
        const int b = m / PB, p = m % PB;
#pragma unroll
        for (int j = 0; j < 2; ++j) {
          const int nbase = n0 + wn * 64 + j * 32;
          if (nbase >= 3104) continue;
          if (nbase >= 3072) {
#pragma unroll
            for (int g = 0; g < 4; ++g) {
              float4 zv = make_float4(acc[i][j][4 * g], acc[i][j][4 * g + 1], acc[i][j][4 * g + 2], acc[i][j][4 * g + 3]);
              *(float4*)(P.z + (size_t)m * 32 + (nbase - 3072) + 8 * g + 4 * lh) = zv;
            }
            continue;
          }
          const float sc = (nbase >= 1536 && nbase < 1792) ? 0.125f : 1.f;
#pragma unroll
          for (int gp = 0; gp < 4; gp += 2) {
            const u32x4 v = merge_groups(pack4u(acc[i][j][4 * gp] * sc, acc[i][j][4 * gp + 1] * sc, acc[i][j][4 * gp + 2] * sc, acc[i][j][4 * gp + 3] * sc),
                                         pack4u(acc[i][j][4 * gp + 4] * sc, acc[i][j][4 * gp + 5] * sc, acc[i][j][4 * gp + 6] * sc, acc[i][j][4 * gp + 7] * sc));
            const int col = nbase + 8 * (gp + lh);
            bfu* dst;
            if (nbase < 1024) {
              const int which = nbase >> 9;
              const int nn = col - which * 512, head = nn >> 6, d = nn & 63;
              dst = (which == 0 ? P.qa : P.ka) + (size_t)(b * 8 + head) * PB * 64 + kq_off(p, d);
            } else if (nbase < 2048) {
              const int which = (nbase - 1536) >> 8;
              const int nn = col - 1536 - which * 256, head = nn >> 6, d = nn & 63;
              dst = (which == 0 ? P.qb : P.kb) + ((size_t)(b * 4 + head) * PB + p) * 64 + d;
            } else {
              dst = P.rb + (size_t)m * 512 + (col - 2560);
            }
            *(u32x4*)dst = v;
          }
        }
      }
    }
  }
}

DI void phase_gemm_inc(const Params& P, char* smem, int bid, int nb) {
  const int NT = 12, MT = 136;
  const int lane = tid_l() & 63, w = tid_l() >> 6, wm = w & 1, wn = w >> 1, lr = lane & 31, lh = lane >> 5;
  bfu* Q = P.qa;
  bfu* Kk = P.qa + (size_t)MTOT * 1024;
  bfu* Vt = Kk + (size_t)MTOT * 256;
  for (int it = 0;; ++it) {
    int mi_, ni_;
    if (!gemm_tile_map(it, bid, nb, MT, NT, mi_, ni_)) break;
    const int m0 = mi_ * 128, n0 = ni_ * 128;
    f32x16 acc[2][2];
    if (ni_ >= 10) {
      gemm_main<false>(P.h, P.win_t, D, m0, n0, smem, acc);
#pragma unroll
      for (int i = 0; i < 2; ++i)
#pragma unroll
        for (int j = 0; j < 2; ++j) {
          const int n = n0 + wn * 64 + j * 32 + lr;
#pragma unroll
          for (int g = 0; g < 4; ++g) {
            const int m = m0 + wm * 64 + i * 32 + g * 8 + lh * 4;
            const int b = m / PB, p = m % PB;
            const int nn = n - 1280, head = nn >> 6, d = nn & 63;
            *(s16x4*)(Vt + (size_t)(b * 4 + head) * PB * 64 + v_off(p, d)) = pack4(acc[i][j][g * 4], acc[i][j][g * 4 + 1], acc[i][j][g * 4 + 2], acc[i][j][g * 4 + 3]);
          }
        }
    } else {
      gemm_main<true>(P.h, P.win_t, D, m0, n0, smem, acc);
#pragma unroll
      for (int i = 0; i < 2; ++i) {
        const int m = m0 + wm * 64 + i * 32 + lr;
        const int b = m / PB, p = m % PB;
        const bool lat = p >= 256;
        const float4* rp = (const float4*)(P.rope + (size_t)(lat ? p - 256 : 0) * 32);
#pragma unroll
        for (int j = 0; j < 2; ++j) {
          const int nbase = n0 + wn * 64 + j * 32;
          float v[16];
#pragma unroll
          for (int g = 0; g < 4; ++g) {
            const int d4 = ((nbase & 63) + 8 * g + 4 * lh) >> 2;
            const float4 cs = rp[d4];
            const float x0 = acc[i][j][4 * g], x1 = acc[i][j][4 * g + 1], x2 = acc[i][j][4 * g + 2], x3 = acc[i][j][4 * g + 3];
            v[4 * g + 0] = lat ? (x0 * cs.x - x1 * cs.y) : x0;
            v[4 * g + 1] = lat ? (x0 * cs.y + x1 * cs.x) : x1;
            v[4 * g + 2] = lat ? (x2 * cs.z - x3 * cs.w) : x2;
            v[4 * g + 3] = lat ? (x2 * cs.w + x3 * cs.z) : x3;
          }
#pragma unroll
          for (int gp = 0; gp < 4; gp += 2) {
            const u32x4 pv = merge_groups(pack4u(v[4 * gp], v[4 * gp + 1], v[4 * gp + 2], v[4 * gp + 3]),
                                          pack4u(v[4 * gp + 4], v[4 * gp + 5], v[4 * gp + 6], v[4 * gp + 7]));
            const int col = nbase + 8 * (gp + lh);
            bfu* dst;
            if (nbase < 1024) dst = Q + (size_t)(b * 16 + (col >> 6)) * PB * 64 + kq_off(p, col & 63);
            else dst = Kk + (size_t)(b * 4 + ((col - 1024) >> 6)) * PB * 64 + kq_off(p, col & 63);
            *(u32x4*)dst = pv;
          }
        }
      }
    }
  }
}

DI float dpp_x1(float v) { return __int_as_float(__builtin_amdgcn_update_dpp(0, __float_as_int(v), 0xB1, 0xf, 0xf, false)); }
DI float dpp_x2(float v) { return __int_as_float(__builtin_amdgcn_update_dpp(0, __float_as_int(v), 0x4E, 0xf, 0xf, false)); }
DI void phase_gemm_wup(const Params& P, int l, int lat_only, char* smem, int bid, int nb) {
  const int NT = 44, MT = lat_only ? 128 : 136;
  const int tid = tid_l(), lane = tid & 63, w = tid >> 6, wm = w & 1, wn = w >> 1, lr = lane & 31, lh = lane >> 5;
  const float* cw = P.conv_w + (size_t)l * 3 * 2 * DFF;
  const float* cb = P.conv_b + (size_t)l * 2 * DFF;
  for (int it = 0;; ++it) {
    int mi_, ni_;
    if (!gemm_tile_map(it, bid, nb, MT, NT, mi_, ni_)) break;
    const int mt = map_mtile(mi_, lat_only), nt = ni_;
    const int m0 = mt * 128, n0 = nt * 128;
    f32x16 acc[2][2];
    gemm_main<false>(P.h, P.wup_t, D, m0, n0, smem, acc);
    const int ch = nt * 64 + wn * 32 + lr;
    const float g0 = cw[ch], g1 = cw[2 * DFF + ch], g2 = cw[4 * DFF + ch], gb = cb[ch];
    const float u0 = cw[DFF + ch], u1 = cw[3 * DFF + ch], u2 = cw[5 * DFF + ch], ubb = cb[DFF + ch];
    float XG[2][4], YG[2][4], XV[2][4], YV[2][4];
#pragma unroll
    for (int i = 0; i < 2; ++i)
#pragma unroll
      for (int g = 0; g < 4; ++g) {
        XG[i][g] = __shfl_xor(acc[i][0][4 * g + 3], 32);
        YG[i][g] = __shfl_xor(acc[i][0][4 * g + 0], 32);
        XV[i][g] = __shfl_xor(acc[i][1][4 * g + 3], 32);
        YV[i][g] = __shfl_xor(acc[i][1][4 * g + 0], 32);
      }
    const int u64 = mt * 2 + wm;
    float* ubp = P.ub + ((size_t)u64 * 4 * DFF + ch) * 2;
#pragma unroll
    for (int i = 0; i < 2; ++i)
#pragma unroll
      for (int g = 0; g < 4; ++g) {
        const float pG = lh ? XG[i][g] : (g > 0 ? XG[i][g - 1] : (i > 0 ? XG[0][3] : 0.f));
        const float pV = lh ? XV[i][g] : (g > 0 ? XV[i][g - 1] : (i > 0 ? XV[0][3] : 0.f));
        const float nG = lh ? (g < 3 ? YG[i][g + 1] : (i < 1 ? YG[1][0] : 0.f)) : YG[i][g];
        const float nV = lh ? (g < 3 ? YV[i][g + 1] : (i < 1 ? YV[1][0] : 0.f)) : YV[i][g];
        float out[4];
#pragma unroll
        for (int q = 0; q < 4; ++q) {
          const float cG = acc[i][0][4 * g + q], cV = acc[i][1][4 * g + q];
          const float lG = q > 0 ? acc[i][0][4 * g + q - 1] : pG, lV = q > 0 ? acc[i][1][4 * g + q - 1] : pV;
          const float rG = q < 3 ? acc[i][0][4 * g + q + 1] : nG, rV = q < 3 ? acc[i][1][4 * g + q + 1] : nV;
          const float gg = g0 * lG + g1 * cG + g2 * rG + gb;
          const float vv = u0 * lV + u1 * cV + u2 * rV + ubb;
          out[q] = siluf(gg) * vv;
        }
        const int rl = i * 32 + 8 * g + 4 * lh;
        {
          const bool b0 = lr & 1, b1 = (lr >> 1) & 1;
          const float r01 = dpp_x1(b0 ? out[0] : out[1]), r23 = dpp_x1(b0 ? out[2] : out[3]);
          const float n0 = b0 ? r01 : out[0], n1 = b0 ? out[1] : r01, n2 = b0 ? r23 : out[2], n3 = b0 ? out[3] : r23;
          const float ra = dpp_x2(b1 ? n0 : n2), rb2 = dpp_x2(b1 ? n1 : n3);
          const float f0 = b1 ? ra : n0, f1 = b1 ? rb2 : n1, f2 = b1 ? n2 : ra, f3 = b1 ? n3 : rb2;
          const int rq = lr & 3;
          const bool first = (i == 0 && g == 0) && (lh == 0) && (rq == 0);
          const bool last = (i == 1 && g == 3) && (lh == 1) && (rq == 3);
          bfu* ap = P.a + (size_t)(m0 + wm * 64 + rl + rq) * DFF + (ch - rq);
          if (!first && !last) *(s16x4*)ap = pack4(f0, f1, f2, f3);
        }
        if (i == 0 && g == 0) {
          if (lh == 0) {
            ubp[0] = acc[0][0][0]; ubp[1] = acc[0][1][0];
            ubp[(size_t)DFF * 2] = acc[0][0][1]; ubp[(size_t)DFF * 2 + 1] = acc[0][1][1];
          }
        }
        if (i == 1 && g == 3) {
          if (lh == 1) {
            ubp[(size_t)2 * DFF * 2] = acc[1][0][14]; ubp[(size_t)2 * DFF * 2 + 1] = acc[1][1][14];
            ubp[(size_t)3 * DFF * 2] = acc[1][0][15]; ubp[(size_t)3 * DFF * 2 + 1] = acc[1][1][15];
          }
        }
      }
  }
}

DI void phase_fix(const Params& P, int l, int lat_only, int bid, int nb) {
  const float* cw = P.conv_w + (size_t)l * 3 * 2 * DFF;
  const float* cb = P.conv_b + (size_t)l * 2 * DFF;
  const int total = 272 * 2 * DFF;
  for (int idx = bid * 256 + tid_l(); idx < total; idx += nb * 256) {
    const int ch = idx % DFF, rr = idx / DFF, which = rr & 1, u = rr >> 1;
    if (lat_only && (u % 68) < 4) continue;
    const int m = u * 64 + (which ? 63 : 0);
    const int p = m % PB;
    const float2* U = (const float2*)P.ub;
    auto ld = [&](int uu, int w4) { return U[(size_t)(uu * 4 + w4) * DFF + ch]; };
    float2 L = make_float2(0.f, 0.f), C, R = make_float2(0.f, 0.f);
    if (which == 0) {
      if ((p != 0) && (p != 256)) L = ld(u - 1, 3);
      C = ld(u, 0);
      R = ld(u, 1);
    } else {
      L = ld(u, 2);
      C = ld(u, 3);
      if ((p != 255) && (p != PB - 1)) R = ld(u + 1, 0);
    }
    const float gg = cw[ch] * L.x + cw[2 * DFF + ch] * C.x + cw[4 * DFF + ch] * R.x + cb[ch];
    const float vv = cw[DFF + ch] * L.y + cw[3 * DFF + ch] * C.y + cw[5 * DFF + ch] * R.y + cb[DFF + ch];
    P.a[(size_t)m * DFF + ch] = f2bf(siluf(gg) * vv);
  }
}

struct AttnState { f32x16 o0, o1; float m, l; };
struct KFrag { bf16x8 k[4]; };
struct VFrag { bf16x8 v[4]; };

DI void attn_init(AttnState& st, float m0, float l0) {
#pragma unroll
  for (int r = 0; r < 16; ++r) { st.o0[r] = 0.f; st.o1[r] = 0.f; }
  st.m = m0; st.l = l0;
}
DI void attn_qload(const bfu* Qblk, int lr, int lh, bf16x8 (&qf)[4]) {
#pragma unroll
  for (int ks = 0; ks < 4; ++ks) qf[ks] = *(const bf16x8*)(Qblk + ks * 512 + (lh * 32 + lr) * 8);
}
DI void attn_kload(KFrag& kf, const bfu* Kblk, int lr, int lh) {
#pragma unroll
  for (int ks = 0; ks < 4; ++ks) kf.k[ks] = *(const bf16x8*)(Kblk + ks * 512 + (lh * 32 + lr) * 8);
}
DI void attn_vload(VFrag& vf, const bfu* Vblk, int lr, int lh) {
#pragma unroll
  for (int q = 0; q < 4; ++q) vf.v[q] = *(const bf16x8*)(Vblk + q * 512 + (lh * 32 + lr) * 8);
}
DI f32x16 attn_scores(const KFrag& kf, const bf16x8 (&qf)[4]) {
  f32x16 s;
#pragma unroll
  for (int r = 0; r < 16; ++r) s[r] = 0.f;
#pragma unroll
  for (int ks = 0; ks < 4; ++ks) s = MFMA(kf.k[ks], qf[ks], s);
  return s;
}
DI void attn_update(AttnState& st, const f32x16& x, const VFrag& vf, float sc) {
  float mx = x[0];
#pragma unroll
  for (int r = 1; r < 16; ++r) mx = fmaxf(mx, x[r]);
  mx = fmaxf(mx, __shfl_xor(mx, 32)) * sc;
  float mn = st.m;
  if (__builtin_amdgcn_ballot_w64(mx > st.m + 8.f) != 0ull) {
    mn = fmaxf(st.m, mx);
    const float alpha = __builtin_amdgcn_exp2f(st.m - mn);
    st.l *= alpha;
#pragma unroll
    for (int r = 0; r < 16; ++r) { st.o0[r] *= alpha; st.o1[r] *= alpha; }
    st.m = mn;
  }
  float p[16];
  f2_t rs2 = {0.f, 0.f};
  const f2_t sc2 = {sc, sc}, nm2 = {-mn, -mn};
#pragma unroll
  for (int r = 0; r < 16; r += 2) {
    const f2_t xv = {x[r], x[r + 1]};
    const f2_t a = __builtin_elementwise_fma(xv, sc2, nm2);
    p[r] = __builtin_amdgcn_exp2f(a[0]); p[r + 1] = __builtin_amdgcn_exp2f(a[1]);
    const f2_t pv = {p[r], p[r + 1]};
    rs2 += pv;
  }
  float rs = rs2[0] + rs2[1];
  rs += __shfl_xor(rs, 32);
  st.l += rs;
#pragma unroll
  for (int s = 0; s < 2; ++s) {
    const bf16x8 pf = pack8(p + 8 * s);
    st.o0 = MFMA(vf.v[s * 2 + 0], pf, st.o0);
    st.o1 = MFMA(vf.v[s * 2 + 1], pf, st.o1);
  }
}
DI void attn_store(const AttnState& st, bfu* Y, int lr, int lh) {
  const float inv = 1.f / st.l;
#pragma unroll
  for (int g = 0; g < 4; ++g) {
    const int d = 8 * g + 4 * lh;
    *(s16x4*)(Y + (size_t)lr * D + d) = pack4(st.o0[4 * g] * inv, st.o0[4 * g + 1] * inv, st.o0[4 * g + 2] * inv, st.o0[4 * g + 3] * inv);
    *(s16x4*)(Y + (size_t)lr * D + 32 + d) = pack4(st.o1[4 * g] * inv, st.o1[4 * g + 1] * inv, st.o1[4 * g + 2] * inv, st.o1[4 * g + 3] * inv);
  }
}
template <class KP, class MF>
DI void attn_run(AttnState& st, const bf16x8 (&qf)[4], const bfu* Kbase, const bfu* Vbase, int nblk, int lr, int lh, KP keypos, MF maskf) {
  KFrag kf;
  attn_kload(kf, Kbase + (size_t)keypos(0) * 64, lr, lh);
  for (int jb = 0; jb < nblk; ++jb) {
    VFrag vf;
    attn_vload(vf, Vbase + (size_t)keypos(jb) * 64, lr, lh);
    KFrag kn;
    const int jn = jb + 1 < nblk ? jb + 1 : jb;
    attn_kload(kn, Kbase + (size_t)keypos(jn) * 64, lr, lh);
    f32x16 s = attn_scores(kf, qf);
    const float sc = maskf(jb, s);
    attn_update(st, s, vf, sc);
    kf = kn;
  }
}

DI void phase_na(const Params& P, int jl, char* smem, int bid, int nb) {
  const int lane = tid_l() & 63, w = tid_l() >> 6, lr = lane & 31, lh = lane >> 5;
  float* rpb = (float*)smem + 64;
  __syncthreads();
  for (int i = tid_l(); i < 8 * 15 * 31; i += 256) rpb[i] = P.na_rpb[(size_t)jl * 8 * 15 * 31 + i] * LOG2E;
  __syncthreads();
  const int n_lat = 4 * 64 * 4, n_ctx = 4 * 8 * 2;
  for (int kk = 0;; ++kk) {
    const int it = ((nb & 7) == 0 && kk < (n_lat + n_ctx) / nb) ? ((kk * 8 + (bid & 7)) * (nb >> 3) + (bid >> 3)) : (kk * nb + bid);
    if (it >= n_lat + n_ctx) break;
    AttnState st;
    attn_init(st, NEGF, 0.f);
    bf16x8 qf[4];
    if (it < n_lat) {
      const int b = it >> 8, hp = (it >> 6) & 3, r = it & 63;
      const int head = hp * 2 + (w >> 1), qblk = w & 1;
      const size_t bh = (size_t)(b * 8 + head);
      const int pq = 256 + r * 64 + qblk * 32;
      attn_qload(P.qa + (bh * PB + pq) * 64, lr, lh, qf);
      const bfu* Kbase = P.ka + bh * PB * 64;
      const bfu* Vbase = P.vaT + bh * 64 * PB;
      int rstart = r - 4; rstart = rstart < 0 ? 0 : (rstart > 56 ? 56 : rstart);
      const int cq = qblk * 32 + lr;
      int cs = cq - 8; cs = cs < 0 ? 0 : (cs > 48 ? 48 : cs);
      unsigned mask0 = 0u, mask1 = 0u;
#pragma unroll
      for (int q = 0; q < 16; ++q) {
        const int k0c = crow(q, lh), k1c = 32 + crow(q, lh);
        mask0 |= ((k0c >= cs) && (k0c < cs + 16)) ? (1u << q) : 0u;
        mask1 |= ((k1c >= cs) && (k1c < cs + 16)) ? (1u << q) : 0u;
      }
      const int dcb0 = 0 - cq + 15 + 4 * lh, dcb1 = 32 - cq + 15 + 4 * lh;
      attn_run(st, qf, Kbase, Vbase, 24, lr, lh,
               [&](int jb) { return jb < 8 ? jb * 32 : 256 + (rstart + ((jb - 8) >> 1)) * 64 + ((jb - 8) & 1) * 32; },
               [&](int jb, f32x16& s) {
                 if (jb < 8) return QSCALE;
                 const int j = jb - 8, rr = j >> 1, par = j & 1;
                 const int dr = rstart + rr - r + 7;
                 const unsigned msk = par ? mask1 : mask0;
                 const float* bp = rpb + (head * 15 + dr) * 31 + (par ? dcb1 : dcb0);
#pragma unroll
                 for (int q = 0; q < 16; ++q) {
                   const float bias = bp[(q & 3) + 8 * (q >> 2)];
                   s[q] = ((msk >> q) & 1u) ? fmaf(s[q], QSCALE, bias) : NEGF;
                 }
                 return 1.f;
               });
      attn_store(st, P.y + ((size_t)b * PB + pq) * D + head * 64, lr, lh);
    } else {
      const int r2 = it - n_lat;
      const int b = r2 >> 4, head = (r2 >> 1) & 7, half = r2 & 1;
      const int qblk = half * 4 + w;
      const size_t bh = (size_t)(b * 8 + head);
      attn_qload(P.qa + (bh * PB + qblk * 32) * 64, lr, lh, qf);
      attn_run(st, qf, P.ka + bh * PB * 64, P.vaT + bh * 64 * PB, 8, lr, lh,
               [&](int jb) { return jb * 32; },
               [&](int jb, f32x16& s) {
                 return QSCALE;
               });
      attn_store(st, P.y + ((size_t)b * PB + qblk * 32) * D + head * 64, lr, lh);
    }
  }
}

DI void phase_swa(const Params& P, int jl, int need_ctx, int bid, int nb) {
  const int lane = tid_l() & 63, w = tid_l() >> 6, lr = lane & 31, lh = lane >> 5;
  const bfu* Q = P.qa;
  const bfu* Kk = P.qa + (size_t)MTOT * 1024;
  const bfu* Vt = Kk + (size_t)MTOT * 256;
  const float* sink = P.swa_sink + jl * 16;
  const int n_lat = 4 * 16 * 32, n_ctx = need_ctx ? 4 * 16 * 2 : 0;
  for (int kk = 0;; ++kk) {
    const int it = ((nb & 7) == 0 && kk < (n_lat + n_ctx) / nb) ? ((kk * 8 + (bid & 7)) * (nb >> 3) + (bid >> 3)) : (kk * nb + bid);
    if (it >= n_lat + n_ctx) break;
    AttnState st;
    bf16x8 qf[4];
    if (it < n_lat) {
      const int b = it >> 9, hq = (it >> 5) & 15, tb = (it & 31) * 4 + w;
      const int kvh = hq >> 2;
      attn_init(st, sink[hq] * LOG2E, 1.f);
      const int pq = 256 + tb * 32;
      attn_qload(Q + ((size_t)(b * 16 + hq) * PB + pq) * 64, lr, lh, qf);
      const bfu* Kbase = Kk + (size_t)(b * 4 + kvh) * PB * 64;
      const bfu* Vbase = Vt + (size_t)(b * 4 + kvh) * 64 * PB;
      const int k_lo = tb - 4 < 0 ? 0 : tb - 4, k_hi = tb + 4 > 127 ? 127 : tb + 4;
      const int tq = tb * 32 + lr;
      attn_run(st, qf, Kbase, Vbase, 8 + (k_hi - k_lo + 1), lr, lh,
               [&](int jb) { return jb < 8 ? jb * 32 : 256 + (k_lo + jb - 8) * 32; },
               [&](int jb, f32x16& s) {
                 const int kb = k_lo + jb - 8;
                 if (jb < 8 || (kb > tb - 4 && kb < tb + 4)) return QSCALE;
#pragma unroll
                 for (int q = 0; q < 16; ++q) {
                   const int tk = kb * 32 + crow(q, lh);
                   int df = tq - tk; df = df < 0 ? -df : df;
                   s[q] = (df <= 128) ? s[q] * QSCALE : NEGF;
                 }
                 return 1.f;
               });
      attn_store(st, P.y + ((size_t)b * PB + pq) * D + hq * 64, lr, lh);
    } else {
      const int r2 = it - n_lat;
      const int b = r2 >> 5, hq = (r2 >> 1) & 15, half = r2 & 1;
      const int qblk = half * 4 + w, kvh = hq >> 2;
      attn_init(st, sink[hq] * LOG2E, 1.f);
      attn_qload(Q + ((size_t)(b * 16 + hq) * PB + qblk * 32) * 64, lr, lh, qf);
      attn_run(st, qf, Kk + (size_t)(b * 4 + kvh) * PB * 64, Vt + (size_t)(b * 4 + kvh) * 64 * PB, 8, lr, lh,
               [&](int jb) { return jb * 32; },
               [&](int jb, f32x16& s) {
                 return QSCALE;
               });
      attn_store(st, P.y + ((size_t)b * PB + qblk * 32) * D + hq * 64, lr, lh);
    }
  }
}

DI void gla_cumsum(const Params& P, int jl, int b, int h, int c, float* LB, float* ZT) {
  const int tid = tid_l(), dk = tid & 63, tg = tid >> 6;
  const float* wa2 = P.gla_wa2 + (size_t)jl * 2 * 16 * 256;
  const float* ba = P.gla_ba + (size_t)jl * 2 * 256;
  {
    const float4* zsrc = (const float4*)(P.z + ((size_t)b * PB + c * 64) * 32);
    ((float4*)ZT)[tid] = zsrc[tid];
    ((float4*)ZT)[tid + 256] = zsrc[tid + 256];
  }
  __syncthreads();
  float lf[16], lbk[16];
#pragma unroll
  for (int dir = 0; dir < 2; ++dir) {
    float wc[16];
#pragma unroll
    for (int r = 0; r < 16; ++r) wc[r] = wa2[(dir * 16 + r) * 256 + h * 64 + dk];
    const float bias = ba[dir * 256 + h * 64 + dk];
#pragma unroll
    for (int tt = 0; tt < 16; ++tt) {
      const int t = tg * 16 + tt;
      const float4* zr = (const float4*)(ZT + t * 32 + dir * 16);
      float acc = bias;
#pragma unroll
      for (int r4 = 0; r4 < 4; ++r4) {
        const float4 zv = zr[r4];
        acc += zv.x * wc[4 * r4] + zv.y * wc[4 * r4 + 1] + zv.z * wc[4 * r4 + 2] + zv.w * wc[4 * r4 + 3];
      }
      const float ls = (fminf(acc, 0.f) - __logf(1.f + __expf(-fabsf(acc)))) * (1.f / 16.f);
      if (dir == 0) lf[tt] = ls; else lbk[tt] = ls;
    }
  }
#pragma unroll
  for (int tt = 1; tt < 16; ++tt) lf[tt] += lf[tt - 1];
#pragma unroll
  for (int tt = 14; tt >= 0; --tt) lbk[tt] += lbk[tt + 1];
  __syncthreads();
  ZT[tg * 64 + dk] = lf[15];
  ZT[256 + tg * 64 + dk] = lbk[0];
  __syncthreads();
  float of = 0.f, ob = 0.f;
#pragma unroll
  for (int g = 0; g < 4; ++g) {
    if (g < tg) of += ZT[g * 64 + dk];
    if (g > tg) ob += ZT[256 + g * 64 + dk];
  }
#pragma unroll
  for (int tt = 0; tt < 16; ++tt) {
    const int t = tg * 16 + tt;
    LB[t * 64 + dk] = lf[tt] + of;
    LB[(64 + t) * 64 + dk] = lbk[tt] + ob;
  }
  __syncthreads();
}

DI void phase_gla1(const Params& P, int jl, char* smem, int bid, int nb) {
  float* LB = (float*)smem;
  bfu* KD = (bfu*)(smem + 32768);
  const int tid = tid_l(), lane = tid & 63, w = tid >> 6, lr = lane & 31, lh = lane >> 5;
  for (int it = bid; it < 16 * 68; it += nb) {
    const int bh = it / 68, c = it % 68, b = bh >> 2, h = bh & 3;
    __syncthreads();
    gla_cumsum(P, jl, b, h, c, LB, (float*)(smem + 49152));
    const bfu* kp = P.kb + ((size_t)bh * PB + c * 64) * 64;
    {
      const int dk = tid & 63;
      const float endf = LB[63 * 64 + dk], endb = LB[64 * 64 + dk];
#pragma unroll
      for (int it2 = 0; it2 < 2; ++it2) {
        const int t0 = ((tid >> 6) + 4 * it2) * 8;
        float vf[8], vb[8];
#pragma unroll
        for (int j = 0; j < 8; ++j) {
          const float kv = bf2f(kp[(t0 + j) * 64 + dk]);
          vf[j] = kv * __expf(endf - LB[(t0 + j) * 64 + dk]);
          vb[j] = kv * __expf(endb - LB[(64 + t0 + j) * 64 + dk]);
        }
        *(bf16x8*)(KD + swz(dk, t0)) = pack8(vf);
        *(bf16x8*)(KD + 4096 + swz(dk, t0)) = pack8(vb);
      }
    }
    if (tid < 128) {
      const int dir = tid >> 6, dk = tid & 63;
      P.decay[((size_t)(dir * 16 + bh) * 68 + c) * 64 + dk] = __expf(dir == 0 ? LB[63 * 64 + dk] : LB[64 * 64 + dk]);
    }
    __syncthreads();
    const int dir = w >> 1, dvh = w & 1;
    f32x16 acc[2][2];
#pragma unroll
    for (int i = 0; i < 2; ++i)
#pragma unroll
      for (int j = 0; j < 2; ++j)
#pragma unroll
        for (int r = 0; r < 16; ++r) acc[i][j][r] = 0.f;
    const bfu* vp = P.vbT + ((size_t)bh * 128 + dvh * 64 + lr) * PB + c * 64;
#pragma unroll
    for (int ks = 0; ks < 4; ++ks) {
      bf16x8 af[2], bfr[2];
#pragma unroll
      for (int i = 0; i < 2; ++i) af[i] = *(const bf16x8*)(KD + dir * 4096 + swz(i * 32 + lr, ks * 16 + lh * 8));
#pragma unroll
      for (int j = 0; j < 2; ++j) bfr[j] = *(const bf16x8*)(vp + (size_t)(j * 32) * PB + ks * 16 + lh * 8);
#pragma unroll
      for (int i = 0; i < 2; ++i)
#pragma unroll
        for (int j = 0; j < 2; ++j) acc[i][j] = MFMA(af[i], bfr[j], acc[i][j]);
    }
    bfu* ds = P.dstate + ((size_t)(dir * 16 + bh) * 68 + c) * 8192;
#pragma unroll
    for (int i = 0; i < 2; ++i)
#pragma unroll
      for (int j = 0; j < 2; ++j)
#pragma unroll
        for (int g = 0; g < 4; ++g) {
          const int dk = i * 32 + 8 * g + 4 * lh, dv = dvh * 64 + j * 32 + lr;
          *(s16x4*)(ds + dv * 64 + dk) = pack4(acc[i][j][4 * g], acc[i][j][4 * g + 1], acc[i][j][4 * g + 2], acc[i][j][4 * g + 3]);
        }
  }
}

DI void phase_gla2(const Params& P, int bid, int nb) {
  bfu* Sin = P.h;
  for (int idx = bid * 256 + tid_l(); idx < 32 * 2048; idx += nb * 256) {
    const int chain = idx >> 11, e4 = idx & 2047;
    const int dir = chain >> 4;
    const int dk = (e4 * 4) & 63;
    float s0 = 0.f, s1 = 0.f, s2 = 0.f, s3 = 0.f;
#pragma unroll 4
    for (int step = 0; step < 68; ++step) {
      const int c = dir == 0 ? step : (step < 4 ? 3 - step : 71 - step);
      const size_t base = ((size_t)chain * 68 + c) * 8192 + e4 * 4;
      *(s16x4*)(Sin + base) = pack4(s0, s1, s2, s3);
      const s16x4 d = *(const s16x4*)(P.dstate + base);
      const float4 dec = *(const float4*)(P.decay + ((size_t)chain * 68 + c) * 64 + dk);
      s0 = dec.x * s0 + bf2f((bfu)d[0]);
      s1 = dec.y * s1 + bf2f((bfu)d[1]);
      s2 = dec.z * s2 + bf2f((bfu)d[2]);
      s3 = dec.w * s3 + bf2f((bfu)d[3]);
    }
  }
}

DI void phase_gla3(const Params& P, int jl, char* smem, int bid, int nb) {
  float* LB = (float*)smem;
  bfu* QT = (bfu*)(smem + 32768);
  bfu* KT = QT + 8192;
  const bfu* Sin = P.h;
  const int tid = tid_l(), lane = tid & 63, w = tid >> 6, lr = lane & 31, lh = lane >> 5;
  const float* gg = P.gla_g + (size_t)jl * 512;
  for (int it = bid; it < 16 * 68; it += nb) {
    const int bh = it / 68, c = it % 68, b = bh >> 2, h = bh & 3;
    __syncthreads();
    bf16x8 vfr[4][2];
    {
      const bfu* vp = P.vbT + ((size_t)bh * 128 + (w >> 1) * 64 + lr) * PB + c * 64;
#pragma unroll
      for (int ks = 0; ks < 4; ++ks)
#pragma unroll
        for (int j = 0; j < 2; ++j) vfr[ks][j] = *(const bf16x8*)(vp + (size_t)(j * 32) * PB + ks * 16 + lh * 8);
    }
    gla_cumsum(P, jl, b, h, c, LB, (float*)KT);
    {
      const bfu* qp = P.qb + ((size_t)bh * PB + c * 64) * 64;
      const bfu* kp = P.kb + ((size_t)bh * PB + c * 64) * 64;
#pragma unroll
      for (int it2 = 0; it2 < 2; ++it2) {
        const int e8 = tid + 256 * it2, t = e8 >> 3, c8 = e8 & 7;
        const bf16x8 q8 = *(const bf16x8*)(qp + t * 64 + c8 * 8);
        const bf16x8 k8 = *(const bf16x8*)(kp + t * 64 + c8 * 8);
        float bfv[8], bbv[8];
        *(float4*)&bfv[0] = *(const float4*)(LB + t * 64 + c8 * 8);
        *(float4*)&bfv[4] = *(const float4*)(LB + t * 64 + c8 * 8 + 4);
        *(float4*)&bbv[0] = *(const float4*)(LB + (64 + t) * 64 + c8 * 8);
        *(float4*)&bbv[4] = *(const float4*)(LB + (64 + t) * 64 + c8 * 8 + 4);
        float qf_[8], kf_[8], qb_[8], kb_[8];
#pragma unroll
        for (int j = 0; j < 8; ++j) {
          const float qv = bf2f((bfu)q8[j]), kv = bf2f((bfu)k8[j]);
          qf_[j] = qv * __expf(bfv[j]); kf_[j] = kv * __expf(-bfv[j]);
          qb_[j] = qv * __expf(bbv[j]); kb_[j] = kv * __expf(-bbv[j]);
        }
        const int a = swz(t, c8 * 8);
        *(bf16x8*)(QT + a) = pack8(qf_); *(bf16x8*)(KT + a) = pack8(kf_);
        *(bf16x8*)(QT + 4096 + a) = pack8(qb_); *(bf16x8*)(KT + 4096 + a) = pack8(kb_);
      }
    }
    __syncthreads();
    {
      const int dir = w >> 1, qh = w & 1;
      f32x16 att[2];
#pragma unroll
      for (int j = 0; j < 2; ++j)
#pragma unroll
        for (int r = 0; r < 16; ++r) att[j][r] = 0.f;
#pragma unroll
      for (int ks = 0; ks < 4; ++ks) {
        const bf16x8 a = *(const bf16x8*)(QT + dir * 4096 + swz(qh * 32 + lr, ks * 16 + lh * 8));
#pragma unroll
        for (int j = 0; j < 2; ++j) {
          const bf16x8 bb = *(const bf16x8*)(KT + dir * 4096 + swz(j * 32 + lr, ks * 16 + lh * 8));
          att[j] = MFMA(a, bb, att[j]);
        }
      }
      __syncthreads();
#pragma unroll
      for (int j = 0; j < 2; ++j)
#pragma unroll
        for (int r = 0; r < 16; ++r) {
          const int tq = qh * 32 + crow(r, lh), tk = j * 32 + lr;
          const bool keep = dir == 0 ? (tk <= tq) : (tk >= tq);
          KT[dir * 4096 + swz(tq, tk)] = f2bf(keep ? att[j][r] : 0.f);
        }
    }
    __syncthreads();
    {
      const int qh = w & 1, dvh = w >> 1;
      f32x16 o[2];
#pragma unroll
      for (int j = 0; j < 2; ++j)
#pragma unroll
        for (int r = 0; r < 16; ++r) o[j][r] = 0.f;
#pragma unroll
      for (int dir = 0; dir < 2; ++dir) {
        const bfu* sp = Sin + ((size_t)(dir * 16 + bh) * 68 + c) * 8192 + (size_t)(dvh * 64 + lr) * 64;
#pragma unroll
        for (int ks = 0; ks < 4; ++ks) {
          const bf16x8 a1 = *(const bf16x8*)(KT + dir * 4096 + swz(qh * 32 + lr, ks * 16 + lh * 8));
          const bf16x8 a2 = *(const bf16x8*)(QT + dir * 4096 + swz(qh * 32 + lr, ks * 16 + lh * 8));
#pragma unroll
          for (int j = 0; j < 2; ++j) {
            const bf16x8 b1 = vfr[ks][j];
            const bf16x8 b2 = *(const bf16x8*)(sp + (size_t)(j * 32) * 64 + ks * 16 + lh * 8);
            o[j] = MFMA(a1, b1, o[j]);
            o[j] = MFMA(a2, b2, o[j]);
          }
        }
      }
#pragma unroll
      for (int j = 0; j < 2; ++j)
#pragma unroll
        for (int r = 0; r < 16; ++r) LB[(qh * 32 + crow(r, lh)) * 128 + dvh * 64 + j * 32 + lr] = o[j][r];
    }
    __syncthreads();
    {
      const int t = tid >> 2, seg = tid & 3;
      float4 ov[8];
      float ss = 0.f;
#pragma unroll
      for (int k = 0; k < 8; ++k) {
        const int kk = (k + t) & 7;
        ov[k] = *(const float4*)(LB + t * 128 + seg * 32 + kk * 4);
        ss += ov[k].x * ov[k].x + ov[k].y * ov[k].y + ov[k].z * ov[k].z + ov[k].w * ov[k].w;
      }
      ss += __shfl_xor(ss, 1);
      ss += __shfl_xor(ss, 2);
      const float rs = rsqrtf(ss * (1.f / 128.f) + EPSF);
      const size_t m = (size_t)b * PB + c * 64 + t;
#pragma unroll
      for (int k = 0; k < 8; ++k) {
        const int kk = (k + t) & 7;
        const int col = h * 128 + seg * 32 + kk * 4;
        const s16x4 rv = *(const s16x4*)(P.rb + m * 512 + col);
        const float4 g4 = *(const float4*)(gg + col);
        *(s16x4*)(P.y + m * D + 512 + col) = pack4(ov[k].x * rs * g4.x * siluf(bf2f((bfu)rv[0])), ov[k].y * rs * g4.y * siluf(bf2f((bfu)rv[1])),
                                                   ov[k].z * rs * g4.z * siluf(bf2f((bfu)rv[2])), ov[k].w * rs * g4.w * siluf(bf2f((bfu)rv[3])));
      }
    }
  }
}

__global__ void __launch_bounds__(256, 2) mega(Params P) {
  cg::grid_group grid = cg::this_grid();
  __shared__ __attribute__((aligned(16))) char smem[65536];
  const int bid = blockIdx.x, nb = gridDim.x;
  XcdBarrier xb = xcd_barrier_post(P.bar);
#define GSYNC() xcd_barrier(xb)

  for (int rep = 0; rep < REP_CONV; ++rep) { phase_convert_layer(P, 0, smem, bid, nb);
  phase_modp(P, smem, bid, nb);
  phase_rope(P, bid, nb); }
  if (P.out == nullptr) grid.sync();
  GSYNC();
  phase_modreduce(P, bid, nb);
  GSYNC();
  phase_rows0(P, 0, 0, nullptr, nullptr, P.g_mix_pre, P.mod + 0 * 1024, P.mod + 1 * 1024, bid, nb);
  GSYNC();

#pragma unroll 1
  for (int l = 0; l < 4; ++l) {
    const int jl = l >> 1;
    const int last = (l == 3);
    const float* modl = P.mod + (size_t)l * 5 * 6144;
    if ((l & 1) == 0) {
      for (int rep = 0; rep < REP_GEMM; ++rep) phase_gemm_inab(P, smem, bid, nb);
      GSYNC();
      for (int rep = 0; rep < REP_MIX; ++rep) { phase_na(P, jl, smem, bid, nb);
      phase_gla1(P, jl, smem, bid, nb); }
      GSYNC();
      for (int rep = 0; rep < REP_MIX; ++rep) phase_gla2(P, bid, nb);
      GSYNC();
      for (int rep = 0; rep < REP_MIX; ++rep) phase_gla3(P, jl, smem, bid, nb);
      GSYNC();
    } else {
      for (int rep = 0; rep < REP_GEMM; ++rep) phase_gemm_inc(P, smem, bid, nb);
      GSYNC();
      for (int rep = 0; rep < REP_MIX; ++rep) phase_swa(P, jl, !last, bid, nb);
      GSYNC();
    }
    for (int rep = 0; rep < REP_GEMM; ++rep) phase_gemm_f32(P, P.y, P.wout_t, D, D, (bfu*)P.yo, last, smem, bid, nb);
    GSYNC();
    phase_rows(P, 1, last, P.g_mix_post + l * D, modl + 2 * 1024, P.g_ffn_pre + l * D, modl + 3 * 1024, modl + 4 * 1024, bid, nb);
    GSYNC();
    for (int rep = 0; rep < REP_GEMM; ++rep) phase_gemm_wup(P, l, last, smem, bid, nb);
    GSYNC();
    phase_fix(P, l, last, bid, nb);
    GSYNC();
    for (int rep = 0; rep < REP_GEMM; ++rep) phase_gemm_f32(P, P.a, P.wdown_t, DFF, D, (bfu*)P.yo, last, smem, bid, nb);
    GSYNC();
    if (!last) {
      const float* modn = P.mod + (size_t)(l + 1) * 5 * 6144;
      phase_rows(P, 1, 0, P.g_ffn_post + l * D, modl + 5 * 1024, P.g_mix_pre + (l + 1) * D, modn + 0 * 1024, modn + 1 * 1024, bid, nb);
      for (int rep = 0; rep < REP_CONV; ++rep) phase_convert_layer(P, l + 1, smem, bid, nb);
      GSYNC();
    } else {
      phase_rows(P, 2, 1, P.g_ffn_post + l * D, modl + 5 * 1024, nullptr, nullptr, nullptr, bid, nb);
    }
  }
}

extern "C" void kernel_launch(void* const* d_in, const int* in_sizes, int n_in, void* d_out,
                              int out_size, void* d_ws, size_t ws_size, hipStream_t stream) {
  static int grid_blocks = 0;
  if (!grid_blocks) {
    int dev = 0, cus = 0, per_cu = 0;
    (void)hipGetDevice(&dev);
    (void)hipDeviceGetAttribute(&cus, hipDeviceAttributeMultiprocessorCount, dev);
    (void)hipOccupancyMaxActiveBlocksPerMultiprocessor(&per_cu, mega, 256, 0);
    if (per_cu > 2) per_cu = 2;
    if (per_cu < 1) per_cu = 1;
    grid_blocks = cus * per_cu;
  }
  Params p{};
  const float* const* in = (const float* const*)d_in;
  p.x = in[0]; p.c = in[1]; p.ctx = in[2]; p.c_ctx = in[3]; p.w_mod = in[4]; p.b_mod = in[5];
  p.g_mix_pre = in[6]; p.g_mix_post = in[7]; p.g_ffn_pre = in[8]; p.g_ffn_post = in[9];
  p.w_out = in[10]; p.w_up = in[11]; p.conv_w = in[12]; p.conv_b = in[13]; p.w_down = in[14];
  p.w_in_ab = in[15]; p.na_rpb = in[16]; p.gla_wa2 = in[17]; p.gla_ba = in[18]; p.gla_g = in[19];
  p.w_in_c = in[20]; p.swa_sink = in[21];
  p.out = (float*)d_out;
  char* base = (char*)d_ws;
  size_t off = 0;
  auto take = [&](size_t bytes) { char* r = base + off; off += (bytes + 255) & ~(size_t)255; return r; };
  const size_t M = MTOT;
  p.bar = (unsigned*)take((size_t)XCD_BAR_WORDS * 4);
  p.wout_t = (bfu*)take((size_t)1024 * 1024 * 2);
  p.wup_t = (bfu*)take((size_t)5632 * 1024 * 2);
  p.wdown_t = (bfu*)take((size_t)1024 * 2816 * 2);
  p.win_t = (bfu*)take((size_t)3200 * 1024 * 2);
  p.modp = (float*)take((size_t)4 * 32 * 5 * 6144 * 4);
  p.mod = (float*)take((size_t)4 * 5 * 6144 * 4);
  p.rope = (float2*)take((size_t)4096 * 32 * 8);
  p.xres = (float*)take(M * 1024 * 4);
  p.h = (bfu*)take(M * 1024 * 2);
  char* ra = take(0);
  p.yo = (float*)ra;
  p.qa = (bfu*)ra;
  p.ka = p.qa + M * 512;
  p.vaT = p.ka + M * 512;
  p.qb = p.vaT + M * 512;
  p.kb = p.qb + M * 256;
  char* rb2 = ra + M * 4096;
  p.a = (bfu*)rb2;
  p.y = (bfu*)rb2;
  p.vbT = p.y + M * 1024;
  p.rb = p.vbT + M * 512;
  p.z = (float*)(p.rb + M * 512);
  p.decay = p.z + M * 32;
  char* rc = rb2 + M * 2816 * 2;
  p.ub = (float*)rc;
  p.dstate = (bfu*)rc;
  off += M * 4096 + M * 2816 * 2 + (size_t)2 * 16 * 68 * 8192 * 2 + 4096;
  if (off > ws_size) {
    fprintf(stderr, "workspace too small: need %zu have %zu\n", off, ws_size);
    return;
  }
  (void)hipMemsetAsync(p.bar, 0, (size_t)XCD_BAR_WORDS * 4, stream);
  void* args[] = {&p};
  hipError_t e = hipLaunchCooperativeKernel((void*)mega, dim3(grid_blocks), dim3(256), args, 0, stream);
  if (e != hipSuccess) fprintf(stderr, "cooperative launch failed: %s (grid %d)\n", hipGetErrorString(e), grid_blocks);
}
```
